# Optimizing an MI355X kernel written in HIP

```python
import math
import jax, jax.numpy as jnp
from jax import lax
import numpy as np

D_MODEL = 2048
BATCH = 16
SEQ = 2048
DEPTH = 2
DEC_BATCH = 4
DEC_SEQ = 8192
PAST_LEN = 128

N_HEADS = 8
HEAD_DIM = 128
V_DIM = 2 * HEAD_DIM
QK_WIDTH = N_HEADS * 2 * HEAD_DIM
ATTN_WIDTH = N_HEADS * V_DIM
Q_BLOCK = 128
N_FGROUPS = 8
FGROUP_DIM = 128
FNET_WIDTH = N_FGROUPS * FGROUP_DIM
IN_WIDTH = 2 * QK_WIDTH + ATTN_WIDTH + FNET_WIDTH + 2 * D_MODEL
D_FF = ((8 * D_MODEL + 3 * 256 - 1) // (3 * 256)) * 256
N_BUCKETS = 32
MAX_DISTANCE = 128
ALPHA = (2.0 * DEPTH) ** 0.25
BETA = (8.0 * DEPTH) ** -0.25
LN_EPS = 1e-5

kernel_name = "hybrid_diffattn_fnet_gated_encoder"


def _layernorm(x, g, b):
    xf = x.astype(jnp.float32)
    mu = jnp.mean(xf, axis=-1, keepdims=True)
    var = jnp.mean(jnp.square(xf - mu), axis=-1, keepdims=True)
    return ((xf - mu) * lax.rsqrt(var + LN_EPS) * g.astype(jnp.float32) + b.astype(jnp.float32)).astype(x.dtype)


def _rel_bucket(rel):
    nb = N_BUCKETS // 2
    ret = jnp.where(rel > 0, nb, 0)
    n = jnp.abs(rel)
    max_exact = nb // 2
    nf = jnp.maximum(n, 1).astype(jnp.float32)
    large = max_exact + (jnp.log(nf / max_exact) / math.log(MAX_DISTANCE / max_exact) * (nb - max_exact)).astype(jnp.int32)
    large = jnp.minimum(large, nb - 1)
    return ret + jnp.where(n < max_exact, n, large)


def _diff_attention(q, k, v, lam, rel_bias, lam_init):
    B, S = q.shape[0], q.shape[1]
    nblk = S // Q_BLOCK
    k1 = k[..., 0, :]
    k2 = k[..., 1, :]
    qb = (q * (HEAD_DIM ** -0.5)).reshape(B, nblk, Q_BLOCK, N_HEADS, 2, HEAD_DIM).transpose(1, 0, 3, 2, 4, 5)
    starts = jnp.arange(nblk, dtype=jnp.int32) * Q_BLOCK
    k_pos = jnp.arange(S, dtype=jnp.int32)
    lamf = lam.astype(jnp.float32)
    lam_full = jnp.exp(jnp.sum(lamf[0] * lamf[1])) - jnp.exp(jnp.sum(lamf[2] * lamf[3])) + lam_init

    def block(args):
        qblk, start = args
        q_pos = start + jnp.arange(Q_BLOCK, dtype=jnp.int32)
        bias = rel_bias[_rel_bucket(k_pos[None, :] - q_pos[:, None])]
        bias = bias.transpose(2, 0, 1).astype(jnp.float32)[None]
        s1 = jnp.einsum('bhqd,bshd->bhqs', qblk[..., 0, :], k1).astype(jnp.float32) + bias
        s2 = jnp.einsum('bhqd,bshd->bhqs', qblk[..., 1, :], k2).astype(jnp.float32) + bias
        a = jax.nn.softmax(s1, axis=-1) - lam_full * jax.nn.softmax(s2, axis=-1)
        return jnp.einsum('bhqs,bshd->bqhd', a.astype(v.dtype), v)

    o = lax.map(block, (qb, starts))
    return o.transpose(1, 0, 2, 3, 4).reshape(B, S, N_HEADS, V_DIM)


def _fourier_mix(f):
    B, S = f.shape[0], f.shape[1]
    fg = f.reshape(B, S, N_FGROUPS, FGROUP_DIM).astype(jnp.float32)
    y = jnp.fft.fft2(fg, axes=(1, 3), norm="ortho").real
    return y.reshape(B, S, FNET_WIDTH).astype(f.dtype)


def _layer(x, l, rel_bias, w_in, b_gate, lam, subln_g, w_br_attn, w_br_fnet, w_out,
           ln1_g, ln1_b, w_gu, w_down, ln2_g, ln2_b):
    B, S = x.shape[0], x.shape[1]
    lam_init = 0.8 - 0.6 * math.exp(-0.3 * l)
    h = x @ w_in[l]
    o0 = QK_WIDTH
    o1 = o0 + QK_WIDTH
    o2 = o1 + ATTN_WIDTH
    o3 = o2 + FNET_WIDTH
    q = h[..., :o0].reshape(B, S, N_HEADS, 2, HEAD_DIM)
    k = h[..., o0:o1].reshape(B, S, N_HEADS, 2, HEAD_DIM)
    v = h[..., o1:o2].reshape(B, S, N_HEADS, V_DIM)
    f = h[..., o2:o3]
    g = h[..., o3:] + b_gate[l]

    o = _diff_attention(q, k, v, lam[l], rel_bias, lam_init)
    of = o.astype(jnp.float32)
    of = of * lax.rsqrt(jnp.mean(jnp.square(of), axis=-1, keepdims=True) + LN_EPS)
    o = (of * subln_g[l].astype(jnp.float32) * (1.0 - lam_init)).astype(x.dtype)
    y_attn = o.reshape(B, S, ATTN_WIDTH) @ w_br_attn[l]

    y_fnet = _fourier_mix(f) @ w_br_fnet[l]

    gates = jax.nn.sigmoid(g)
    merged = gates[..., :D_MODEL] * y_attn + gates[..., D_MODEL:] * y_fnet
    x = _layernorm(ALPHA * x + merged @ w_out[l], ln1_g[l], ln1_b[l])

    gu = x @ w_gu[l]
    y_ffn = (jax.nn.silu(gu[..., :D_FF]) * gu[..., D_FF:]) @ w_down[l]
    return _layernorm(ALPHA * x + y_ffn, ln2_g[l], ln2_b[l])


def _trunk(x, rel_bias, ln_in_g, ln_in_b, w_in, b_gate, lam, subln_g, w_br_attn, w_br_fnet,
           w_out, ln1_g, ln1_b, w_gu, w_down, ln2_g, ln2_b):
    x = _layernorm(x, ln_in_g, ln_in_b)
    for l in range(DEPTH):
        x = _layer(x, l, rel_bias, w_in, b_gate, lam, subln_g, w_br_attn, w_br_fnet, w_out,
                   ln1_g, ln1_b, w_gu, w_down, ln2_g, ln2_b)
    return x


def setup_inputs(seed: int = 0) -> dict:
    key = jax.random.key(seed)
    ks = jax.random.split(key, 20)
    f32 = jnp.float32

    def nrm(k, shape, scale):
        return jax.random.normal(k, shape, f32) * scale

    return {
        "x_prompt": nrm(ks[0], (BATCH, SEQ, D_MODEL), 1.0),
        "x_sample": nrm(ks[1], (DEC_BATCH, DEC_SEQ, D_MODEL), 1.0),
        "rel_bias": nrm(ks[2], (N_BUCKETS, N_HEADS), 0.5),
        "ln_in_g": 1.0 + nrm(ks[3], (D_MODEL,), 0.02),
        "ln_in_b": nrm(ks[4], (D_MODEL,), 0.02),
        "w_in": nrm(ks[5], (DEPTH, D_MODEL, IN_WIDTH), D_MODEL ** -0.5),
        "b_gate": nrm(ks[6], (DEPTH, 2 * D_MODEL), 0.02),
        "lam": nrm(ks[7], (DEPTH, 4, HEAD_DIM), 0.1),
        "subln_g": 1.0 + nrm(ks[8], (DEPTH, V_DIM), 0.02),
        "w_br_attn": nrm(ks[9], (DEPTH, ATTN_WIDTH, D_MODEL), ATTN_WIDTH ** -0.5),
        "w_br_fnet": nrm(ks[10], (DEPTH, FNET_WIDTH, D_MODEL), FNET_WIDTH ** -0.5),
        "w_out": nrm(ks[11], (DEPTH, D_MODEL, D_MODEL), BETA * D_MODEL ** -0.5),
        "ln1_g": 1.0 + nrm(ks[12], (DEPTH, D_MODEL), 0.02),
        "ln1_b": nrm(ks[13], (DEPTH, D_MODEL), 0.02),
        "w_gu": nrm(ks[14], (DEPTH, D_MODEL, 2 * D_FF), D_MODEL ** -0.5),
        "w_down": nrm(ks[15], (DEPTH, D_FF, D_MODEL), BETA * D_FF ** -0.5),
        "ln2_g": 1.0 + nrm(ks[16], (DEPTH, D_MODEL), 0.02),
        "ln2_b": nrm(ks[17], (DEPTH, D_MODEL), 0.02),
    }


def reference(x_prompt, x_sample, rel_bias, ln_in_g, ln_in_b, w_in, b_gate, lam, subln_g,
              w_br_attn, w_br_fnet, w_out, ln1_g, ln1_b, w_gu, w_down, ln2_g, ln2_b):
    y_prompt = _trunk(x_prompt, rel_bias, ln_in_g, ln_in_b, w_in, b_gate, lam, subln_g,
                      w_br_attn, w_br_fnet, w_out, ln1_g, ln1_b, w_gu, w_down, ln2_g, ln2_b)
    y_sample = _trunk(x_sample, rel_bias, ln_in_g, ln_in_b, w_in, b_gate, lam, subln_g,
                      w_br_attn, w_br_fnet, w_out, ln1_g, ln1_b, w_gu, w_down, ln2_g, ln2_b)
    return (y_prompt, y_sample)
```

```cpp
#include <hip/hip_runtime.h>
#include <hip/hip_bf16.h>
#include <cstdio>
#include <cstdint>

#ifndef MK_PER_PHASE
#define MK_PER_PHASE 0
#endif

namespace pg8 {
#define PG8_LAS __attribute__((address_space(3)))
typedef unsigned short bf16_t;
typedef short bf16x8 __attribute__((ext_vector_type(8)));
typedef float f32x4 __attribute__((ext_vector_type(4)));
typedef unsigned u32x4 __attribute__((ext_vector_type(4)));
constexpr int BM = 256, BK = 64, HALF = 128, HTB = HALF * BK * 2, STAGE_BYTES = 8 * HTB, NXCD = 8, WGM = 4;

__host__ __device__ __forceinline__ int lds_byte(int r, int c) { const int st = (r >> 4) * 2 + (c >> 5), rr = r & 15, cc = c & 31, ob = rr * 64 + cc * 2; return st * 1024 + (ob ^ (((ob >> 9) & 1) << 5)); }
__host__ __device__ __forceinline__ void stage_rc(int b, int& R, int& C) { const int st = b / 1024, sb = b % 1024, swz = sb ^ (((sb >> 9) & 1) << 5); R = (st >> 1) * 16 + swz / 64; C = (st & 1) * 32 + (swz % 64) / 2; }
__host__ __device__ __forceinline__ int perm32(int rho) { const int n = rho >> 4, i = rho & 15; return 8 * (i >> 2) + 4 * n + (i & 3); }

struct Unit { int pm, pn; };

struct StaticOrder {
    int nM, nN, nwg, G, c;
    __host__ __device__ void init(int M, int N, int G_, int c_) { nM = M / BM; nN = N / BM; nwg = nM * nN; G = G_; c = c_; }
    __host__ __device__ bool next(int i, Unit& u) const {
        const long L = (long)i * G + c; if (L >= nwg) return false;
        int wgid = (int)L; { const int q = nwg / NXCD, r = nwg % NXCD, xcd = wgid % NXCD, off = wgid / NXCD; wgid = (xcd < r ? xcd * (q + 1) : r * (q + 1) + (xcd - r) * q) + off; }
        const int nig = WGM * nN, gid = wgid / nig, fm = gid * WGM, gsz = (nM - fm) < WGM ? (nM - fm) : WGM;
        u.pm = fm + ((wgid % nig) % gsz); u.pn = (wgid % nig) / gsz; return true;
    }
};

struct ProbLin {
    const char* A; const char* B; long aUnit, bUnit, bPm; unsigned rsA, rsB; long hsA, hsB; int K;
    __device__ __forceinline__ const char* abase(const Unit& u) const { return A + (long)u.pm * aUnit; }
    __device__ __forceinline__ const char* bbase(const Unit& u) const { return B + (long)u.pn * bUnit + (long)u.pm * bPm; }
};
__device__ __forceinline__ ProbLin make_lin(const bf16_t* A, int lda, const bf16_t* B, int ldb, int K) {
    ProbLin p; p.A = (const char*)A; p.B = (const char*)B; p.aUnit = (long)BM * lda * 2; p.bUnit = (long)BM * ldb * 2; p.bPm = 0; p.rsA = (unsigned)lda; p.rsB = (unsigned)ldb;
    p.hsA = (long)HALF * lda * 2; p.hsB = (long)HALF * ldb * 2; p.K = K; return p;
}
struct ProbF0 {
    const char* A; const char* B; int lgN2; int K;
    unsigned rsA, rsB; long hsA, hsB;
    __device__ __forceinline__ const char* abase(const Unit& u) const { return A + (long)u.pm * (256L * 2048 * 2); }
    __device__ __forceinline__ const char* bbase(const Unit& u) const { const int bs = 2 * u.pn, b = bs >> lgN2, s2 = bs & ((1 << lgN2) - 1); return B + ((long)b * (128L << lgN2) + s2) * 4096L; }
};

typedef float f32x2_t_ __attribute__((ext_vector_type(2))); typedef __bf16 bf16x2_t_ __attribute__((ext_vector_type(2)));
__device__ __forceinline__ unsigned cvt_pk_bf16(float lo, float hi) { const f32x2_t_ v = {lo, hi}; return __builtin_bit_cast(unsigned, __builtin_convertvector(v, bf16x2_t_)); }
__device__ __forceinline__ float bf_lo(unsigned w) { return __uint_as_float(w << 16); }
__device__ __forceinline__ float bf_hi(unsigned w) { return __uint_as_float(w & 0xffff0000u); }
__device__ __forceinline__ float sigmoidf_(float x) { return __builtin_amdgcn_rcpf(1.0f + __expf(-x)); }

#define PG8_PACK8(v0, v1) ((u32x4){cvt_pk_bf16((v0)[0], (v0)[1]), cvt_pk_bf16((v0)[2], (v0)[3]), cvt_pk_bf16((v1)[0], (v1)[1]), cvt_pk_bf16((v1)[2], (v1)[3])})

struct EpiInProj {
    static constexpr bool PERM = true;
    bf16_t* qkv; bf16_t* gate; const float* bgate;
    __device__ __forceinline__ void operator()(const f32x4 (&acc)[2][2][4][2], const Unit& u, int wr, int wc, int fr, int fq) const {
        const int row0 = u.pm * BM + wr * 64 + fr; const bool isg = u.pn >= 24;
        const int colt = isg ? (u.pn - 24) * BM : u.pn * BM; bf16_t* base = isg ? gate : qkv; const int ldc = isg ? 4096 : 6144;
        const int col0 = colt + wc * 32 + 8 * fq;
        f32x4 bv[2][2];
#pragma unroll
        for (int bj = 0; bj < 2; ++bj)
#pragma unroll
            for (int n = 0; n < 2; ++n) bv[bj][n] = isg ? *(const f32x4*)(bgate + col0 + bj * HALF + 4 * n) * -1.4426950408889634f : (f32x4){0.f, 0.f, 0.f, 0.f};
#pragma unroll
        for (int ai = 0; ai < 2; ++ai)
#pragma unroll
            for (int m = 0; m < 4; ++m) { bf16_t* rowp = base + (size_t)(row0 + ai * HALF + m * 16) * ldc + col0;
#pragma unroll
                for (int bj = 0; bj < 2; ++bj) { f32x4 v0 = acc[ai][bj][m][0] + bv[bj][0], v1 = acc[ai][bj][m][1] + bv[bj][1];
                    if (isg) {
#pragma unroll
                        for (int e = 0; e < 4; ++e) { v0[e] = __builtin_amdgcn_rcpf(1.0f + __builtin_amdgcn_exp2f(v0[e])); v1[e] = __builtin_amdgcn_rcpf(1.0f + __builtin_amdgcn_exp2f(v1[e])); } }
                    *(u32x4*)(rowp + bj * HALF) = PG8_PACK8(v0, v1); } }
    }
};
struct EpiF0 {
    static constexpr bool PERM = true;
    bf16_t* Zt; int lgN2;
    __device__ __forceinline__ void operator()(const f32x4 (&acc)[2][2][4][2], const Unit& u, int wr, int wc, int fr, int fq) const {
#pragma unroll
        for (int bj = 0; bj < 2; ++bj) { const int bs = 2 * u.pn + bj, b = bs >> lgN2, s2 = bs & ((1 << lgN2) - 1);
#pragma unroll
            for (int ai = 0; ai < 2; ++ai)
#pragma unroll
                for (int m = 0; m < 4; ++m) { const int r = u.pm * BM + ai * HALF + wr * 64 + m * 16 + fr;
                    int part, g, c;
                    if (r < 520) { part = 0; g = r / 65; c = r - g * 65; } else { const int q = r - 520; part = 1; g = q / 63; c = q - g * 63 + 1; }
                    const u32x4 v = PG8_PACK8(acc[ai][bj][m][0], acc[ai][bj][m][1]);
                    const size_t a0 = (((((size_t)(b * 1024 + g * 128 + c)) << lgN2) + s2) * 2 + part) * 128 + wc * 32 + 8 * fq;
                    *(u32x4*)(Zt + a0) = v;
                    if (c != 0 && c != 64) { const size_t a1 = (((((size_t)(b * 1024 + g * 128 + 128 - c)) << lgN2) + s2) * 2 + part) * 128 + wc * 32 + 8 * fq;
                        const unsigned sg = part ? 0x80008000u : 0u; *(u32x4*)(Zt + a1) = (u32x4){v[0] ^ sg, v[1] ^ sg, v[2] ^ sg, v[3] ^ sg}; }
                    else *(u32x4*)(Zt + a0 + 128) = (u32x4){0u, 0u, 0u, 0u}; } }
    }
};
struct EpiF1 {
    static constexpr bool PERM = true;
    bf16_t* G2; int lgN2;
    __device__ __forceinline__ void operator()(const f32x4 (&acc)[2][2][4][2], const Unit& u, int wr, int wc, int fr, int fq) const {
#pragma unroll
        for (int bj = 0; bj < 2; ++bj) { const int n = u.pn * BM + bj * HALF + wc * 32 + 8 * fq, bc = n >> lgN2, s2 = n & ((1 << lgN2) - 1);
#pragma unroll
            for (int ai = 0; ai < 2; ++ai)
#pragma unroll
                for (int m = 0; m < 4; ++m) { const int k1 = wr * 64 + m * 16 + fr;
                    const size_t addr = ((((size_t)bc * 128 + k1) * 2 + ai) << lgN2) + s2;
                    *(u32x4*)(G2 + addr) = PG8_PACK8(acc[ai][bj][m][0], acc[ai][bj][m][1]); } }
    }
};
struct EpiF2 {
    static constexpr bool PERM = true;
    bf16_t* Y; int lgN2;
    __device__ __forceinline__ void operator()(const f32x4 (&acc)[2][2][4][2], const Unit& u, int wr, int wc, int fr, int fq) const {
        const int gk = 256 >> lgN2;
#pragma unroll
        for (int ai = 0; ai < 2; ++ai)
#pragma unroll
            for (int m = 0; m < 4; ++m) { const int mm = ai * HALF + wr * 64 + m * 16 + fr, k1l = mm >> lgN2, k2 = mm & ((1 << lgN2) - 1), tok = u.pm * gk + k1l + 128 * k2;
#pragma unroll
                for (int bj = 0; bj < 2; ++bj) { const int n = u.pn * BM + bj * HALF + wc * 32 + 8 * fq, b = n >> 10, ch = n & 1023;
                    const size_t addr = ((size_t)b * (128 << lgN2) + tok) * 1024 + ch;
                    *(u32x4*)(Y + addr) = PG8_PACK8(acc[ai][bj][m][0], acc[ai][bj][m][1]); } }
    }
};
template <bool SECOND> struct EpiGate {
    static constexpr bool PERM = true;
    bf16_t* merged; const bf16_t* gate; int goff;
    __device__ __forceinline__ void operator()(const f32x4 (&acc)[2][2][4][2], const Unit& u, int wr, int wc, int fr, int fq) const {
        const int row0 = u.pm * BM + wr * 64 + fr, col0 = u.pn * BM + wc * 32 + 8 * fq;
        constexpr int MB = SECOND ? 2 : 4;
#pragma unroll
        for (int ai = 0; ai < 2; ++ai)
#pragma unroll
          for (int mb = 0; mb < 4; mb += MB) { u32x4 gq[MB][2], oq[MB][2];
#pragma unroll
            for (int m = 0; m < MB; ++m)
#pragma unroll
                for (int bj = 0; bj < 2; ++bj) { const size_t row = (size_t)(row0 + ai * HALF + (mb + m) * 16); const int col = col0 + bj * HALF;
                    gq[m][bj] = *(const u32x4*)(gate + row * 4096 + goff + col); if (SECOND) oq[m][bj] = *(const u32x4*)(merged + row * 2048 + col); }
            asm volatile("" ::: "memory");
#pragma unroll
            for (int m = 0; m < MB; ++m)
#pragma unroll
                for (int bj = 0; bj < 2; ++bj) { const size_t row = (size_t)(row0 + ai * HALF + (mb + m) * 16); const int col = col0 + bj * HALF; const u32x4 g = gq[m][bj];
                    f32x4 v0 = acc[ai][bj][mb + m][0], v1 = acc[ai][bj][mb + m][1];
                    v0[0] *= bf_lo(g.x); v0[1] *= bf_hi(g.x); v0[2] *= bf_lo(g.y); v0[3] *= bf_hi(g.y);
                    v1[0] *= bf_lo(g.z); v1[1] *= bf_hi(g.z); v1[2] *= bf_lo(g.w); v1[3] *= bf_hi(g.w);
                    if (SECOND) { const u32x4 o = oq[m][bj];
                        v0[0] += bf_lo(o.x); v0[1] += bf_hi(o.x); v0[2] += bf_lo(o.y); v0[3] += bf_hi(o.y);
                        v1[0] += bf_lo(o.z); v1[1] += bf_hi(o.z); v1[2] += bf_lo(o.w); v1[3] += bf_hi(o.w); }
                    *(u32x4*)(merged + row * 2048 + col) = PG8_PACK8(v0, v1); }
            asm volatile("" ::: "memory"); }
    }
};
__device__ __forceinline__ float xsum16(float v) { auto r = __builtin_amdgcn_permlane16_swap(__float_as_uint(v), __float_as_uint(v), false, false); return __uint_as_float(r[0]) + __uint_as_float(r[1]); }
__device__ __forceinline__ float xsum32(float v) { auto r = __builtin_amdgcn_permlane32_swap(__float_as_uint(v), __float_as_uint(v), false, false); return __uint_as_float(r[0]) + __uint_as_float(r[1]); }
template <bool SRCF32, bool EMIT> struct EpiResB {
    static constexpr bool PERM = true;
    const void* src; bf16_t* dst; float alpha; const float* must; const float* gam; const float* bet; float* statp; PG8_LAS float* lred;
    __device__ __forceinline__ void operator()(const f32x4 (&acc)[2][2][4][2], const Unit& u, int wr, int wc, int fr, int fq) const {
        const int row0 = u.pm * BM + wr * 64 + fr, col0 = u.pn * BM + wc * 32 + 8 * fq;
        f32x4 gv[2][2], bv[2][2];
#pragma unroll
        for (int bj = 0; bj < 2; ++bj)
#pragma unroll
            for (int n = 0; n < 2; ++n) { gv[bj][n] = *(const f32x4*)(gam + col0 + bj * HALF + 4 * n); bv[bj][n] = *(const f32x4*)(bet + col0 + bj * HALF + 4 * n); }
        constexpr int MB = (SRCF32 ? 2 : 4) / (EMIT ? 2 : 1);
#pragma unroll
        for (int ai = 0; ai < 2; ++ai)
#pragma unroll
          for (int mb = 0; mb < 4; mb += MB) { float2 ms[MB]; u32x4 xb[MB][2]; f32x4 xf[MB][2][2];
#pragma unroll
            for (int m = 0; m < MB; ++m) { const size_t ro = (size_t)(row0 + ai * HALF + (mb + m) * 16); ms[m] = *(const float2*)(must + ro * 2);
#pragma unroll
                for (int bj = 0; bj < 2; ++bj) { const size_t o = ro * 2048 + col0 + bj * HALF;
                    if (SRCF32) { xf[m][bj][0] = *(const f32x4*)((const float*)src + o); xf[m][bj][1] = *(const f32x4*)((const float*)src + o + 4); }
                    else xb[m][bj] = *(const u32x4*)((const bf16_t*)src + o); } }
            asm volatile("" ::: "memory");
#pragma unroll
            for (int m = 0; m < MB; ++m) { const size_t ro = (size_t)(row0 + ai * HALF + (mb + m) * 16); float s = 0.f, q = 0.f;
#pragma unroll
                for (int bj = 0; bj < 2; ++bj) { const size_t o = ro * 2048 + col0 + bj * HALF; f32x4 x0, x1;
                    if (SRCF32) { x0 = xf[m][bj][0]; x1 = xf[m][bj][1]; }
                    else { const u32x4 w = xb[m][bj]; x0 = (f32x4){bf_lo(w.x), bf_hi(w.x), bf_lo(w.y), bf_hi(w.y)}; x1 = (f32x4){bf_lo(w.z), bf_hi(w.z), bf_lo(w.w), bf_hi(w.w)}; }
                    x0 = (x0 - ms[m].x) * ms[m].y * gv[bj][0] + bv[bj][0]; x1 = (x1 - ms[m].x) * ms[m].y * gv[bj][1] + bv[bj][1];
                    const f32x4 v0 = x0 * alpha + acc[ai][bj][mb + m][0], v1 = x1 * alpha + acc[ai][bj][mb + m][1];
                    if (EMIT) { s += ((v0[0] + v0[1]) + (v0[2] + v0[3])) + ((v1[0] + v1[1]) + (v1[2] + v1[3]));
                        q += ((v0[0] * v0[0] + v0[1] * v0[1]) + (v0[2] * v0[2] + v0[3] * v0[3])) + ((v1[0] * v1[0] + v1[1] * v1[1]) + (v1[2] * v1[2] + v1[3] * v1[3])); }
                    *(u32x4*)(dst + o) = PG8_PACK8(v0, v1); }
                if (EMIT) { s = xsum16(s); s = xsum32(s); q = xsum16(q); q = xsum32(q);
                    if (fq == 0) { PG8_LAS float* d = lred + ((ai * HALF + wr * 64 + (mb + m) * 16 + fr) * 4 + wc) * 2; d[0] = s; d[1] = q; } } }
            asm volatile("" ::: "memory"); }
        if (EMIT) {
            asm volatile("s_waitcnt lgkmcnt(0)" ::: "memory"); __builtin_amdgcn_s_barrier(); asm volatile("" ::: "memory");
            const int t = (wr * 4 + wc) * 64 + fq * 16 + fr;
            if (t < 256) { const PG8_LAS f32x4* d = (const PG8_LAS f32x4*)(lred + t * 8); const f32x4 a = d[0], b = d[1];
                float2 o2; o2.x = (a[0] + a[2]) + (b[0] + b[2]); o2.y = (a[1] + a[3]) + (b[1] + b[3]);
                *(float2*)(statp + ((size_t)(u.pm * BM + t) * 8 + u.pn) * 2) = o2; }
        }
    }
};
struct EpiSwiGLU {
    static constexpr bool PERM = true;
    bf16_t* act; const float* must; const float* c1; const float* c2;
    __device__ __forceinline__ void operator()(const f32x4 (&acc)[2][2][4][2], const Unit& u, int wr, int wc, int fr, int fq) const {
        const int row0 = u.pm * BM + wr * 64 + fr, col0 = u.pn * HALF + wc * 32 + 8 * fq, n0 = u.pn * BM + wc * 32 + 8 * fq;
        f32x4 k1[2][2], k2[2][2]; float2 ms[2][4];
#pragma unroll
        for (int bj = 0; bj < 2; ++bj)
#pragma unroll
            for (int n = 0; n < 2; ++n) { k1[bj][n] = *(const f32x4*)(c1 + n0 + bj * HALF + 4 * n); k2[bj][n] = *(const f32x4*)(c2 + n0 + bj * HALF + 4 * n); }
#pragma unroll
        for (int ai = 0; ai < 2; ++ai)
#pragma unroll
            for (int m = 0; m < 4; ++m) ms[ai][m] = *(const float2*)(must + (size_t)(row0 + ai * HALF + m * 16) * 2);
#pragma unroll
        for (int ai = 0; ai < 2; ++ai)
#pragma unroll
            for (int m = 0; m < 4; ++m) { const int row = row0 + ai * HALF + m * 16; const float mu = ms[ai][m].x, rs = ms[ai][m].y; f32x4 v0, v1;
#pragma unroll
                for (int e = 0; e < 4; ++e) {
                    const float g0 = rs * (acc[ai][0][m][0][e] - mu * k1[0][0][e]) + k2[0][0][e], g1 = rs * (acc[ai][0][m][1][e] - mu * k1[0][1][e]) + k2[0][1][e];
                    const float u0 = rs * (acc[ai][1][m][0][e] - mu * k1[1][0][e]) + k2[1][0][e], u1 = rs * (acc[ai][1][m][1][e] - mu * k1[1][1][e]) + k2[1][1][e];
                    v0[e] = g0 * sigmoidf_(g0) * u0; v1[e] = g1 * sigmoidf_(g1) * u1; }
                *(u32x4*)(act + (size_t)row * 5632 + col0) = PG8_PACK8(v0, v1); }
    }
};

template <class Prob, class Epi, class Sched>
__device__ __forceinline__ void gemm_phase(PG8_LAS unsigned char* lds, const Prob g, const Sched& S, const Epi& E) {
    int tid_ = threadIdx.x; asm volatile("" : "+v"(tid_));
    const int tid = tid_, wid = __builtin_amdgcn_readfirstlane(tid >> 6), lane = tid & 63, wr = wid >> 2, wc = wid & 3, fr = lane & 15, fq = lane >> 4;
    const int nt = g.K / BK;
    unsigned voffA[2], voffB[2];
#pragma unroll
    for (int i = 0; i < 2; ++i) { int R, C; stage_rc(tid * 16 + i * 8192, R, C); const int Rb = Epi::PERM ? ((R & ~31) + perm32(R & 31)) : R;
        voffA[i] = ((unsigned)R * g.rsA + (unsigned)C) * 2u; voffB[i] = ((unsigned)Rb * g.rsB + (unsigned)C) * 2u; }
    const size_t kstep = (size_t)(BK * 2);
    const long hstepA = g.hsA, hstepB = g.hsB;
    const unsigned ldsw = (unsigned)wid * 1024u;
    const int aoff = lds_byte(wr * 64 + fr, fq * 8), boff = lds_byte(wc * 32 + fr, fq * 8);
#define PG8_SA(b, h) (((b) * 2 + (h)) * HTB)
#define PG8_SB(b, h) ((4 + (b) * 2 + (h)) * HTB)
#define PG8_STAGE(bufoff, gbase, voff) do { _Pragma("unroll") for (int _i = 0; _i < 2; ++_i) \
        __builtin_amdgcn_global_load_lds((const unsigned*)((const char*)(gbase) + (voff)[_i]), (PG8_LAS unsigned*)(lds + (bufoff) + ldsw + _i * 8192), 16, 0, 0); } while (0)
#define PG8_LDA(dst, b, h) do { _Pragma("unroll") for (int m = 0; m < 4; ++m) _Pragma("unroll") for (int k = 0; k < 2; ++k) dst[m][k] = *(const PG8_LAS bf16x8*)(lds + PG8_SA(b, h) + aoff + m * 2048 + k * 1024); } while (0)
#define PG8_LDB(dst, b, h) do { _Pragma("unroll") for (int n = 0; n < 2; ++n) _Pragma("unroll") for (int k = 0; k < 2; ++k) dst[n][k] = *(const PG8_LAS bf16x8*)(lds + PG8_SB(b, h) + boff + n * 2048 + k * 1024); } while (0)
#define PG8_MMA(ai, bj, At, Bt) do { __builtin_amdgcn_s_setprio(1); _Pragma("unroll") for (int m = 0; m < 4; ++m) _Pragma("unroll") for (int n = 0; n < 2; ++n) _Pragma("unroll") for (int k = 0; k < 2; ++k) \
        acc[ai][bj][m][n] = __builtin_amdgcn_mfma_f32_16x16x32_bf16(Bt[n][k], At[m][k], acc[ai][bj][m][n], 0, 0, 0); __builtin_amdgcn_s_setprio(0); } while (0)
#define PG8_WAIT_V(n) asm volatile("s_waitcnt vmcnt(" #n ")" ::: "memory")
#define PG8_WAIT_L(n) asm volatile("s_waitcnt lgkmcnt(" #n ")" ::: "memory")
#define PG8_BAR __builtin_amdgcn_s_barrier()
#define PG8_SCHED __builtin_amdgcn_sched_barrier(0)
    Unit cur, nxt; int ui = 0;
    if (!S.next(0, cur)) return;
    f32x4 acc[2][2][4][2];
#pragma unroll
    for (int a = 0; a < 2; ++a)
#pragma unroll
        for (int b = 0; b < 2; ++b)
#pragma unroll
            for (int m = 0; m < 4; ++m)
#pragma unroll
                for (int n = 0; n < 2; ++n) acc[a][b][m][n] = (f32x4){0.f, 0.f, 0.f, 0.f};
    bf16x8 At[4][2], B0[2][2], B1[2][2];
    const char* cA = g.abase(cur); const char* cB = g.bbase(cur);
    PG8_STAGE(PG8_SB(0, 0), cB, voffB); PG8_STAGE(PG8_SB(0, 1), cB + hstepB, voffB); PG8_STAGE(PG8_SA(0, 0), cA, voffA); PG8_STAGE(PG8_SA(0, 1), cA + hstepA, voffA);
    if (wr == 1) PG8_BAR;
    PG8_WAIT_V(2); PG8_BAR;
    PG8_STAGE(PG8_SB(1, 0), cB + kstep, voffB); PG8_STAGE(PG8_SA(1, 0), cA + kstep, voffA); PG8_STAGE(PG8_SB(1, 1), cB + hstepB + kstep, voffB);
    PG8_WAIT_V(6); PG8_BAR;
    for (;;) {
        const bool has_next = S.next(ui + 1, nxt);
        const char* nA = has_next ? g.abase(nxt) : cA; const char* nB = has_next ? g.bbase(nxt) : cB;
        for (int t = 0; t < nt; t += 2) {
            const bool last = (t == nt - 2);
            const char* a1 = cA + (size_t)(t + 1) * kstep;
            const char* a2 = last ? nA : cA + (size_t)(t + 2) * kstep; const char* b2 = last ? nB : cB + (size_t)(t + 2) * kstep;
            const char* a3 = a2 + kstep; const char* b3 = b2 + kstep;
            PG8_LDB(B0, 0, 0); PG8_LDB(B1, 0, 1); PG8_SCHED; PG8_LDA(At, 0, 0); PG8_STAGE(PG8_SA(1, 1), a1 + hstepA, voffA);
            PG8_WAIT_V(8); PG8_WAIT_L(0); PG8_BAR; PG8_MMA(0, 0, At, B0); PG8_MMA(0, 1, At, B1); PG8_BAR; PG8_SCHED;
            PG8_LDA(At, 0, 1); PG8_STAGE(PG8_SB(0, 0), b2, voffB); PG8_STAGE(PG8_SB(0, 1), b2 + hstepB, voffB); PG8_STAGE(PG8_SA(0, 0), a2, voffA);
            PG8_WAIT_V(8); PG8_WAIT_L(0); PG8_BAR; PG8_MMA(1, 0, At, B0); PG8_MMA(1, 1, At, B1); PG8_BAR; PG8_SCHED;
            PG8_LDB(B0, 1, 0); PG8_LDB(B1, 1, 1); PG8_SCHED; PG8_LDA(At, 1, 0); PG8_STAGE(PG8_SA(0, 1), a2 + hstepA, voffA);
            PG8_WAIT_V(8); PG8_WAIT_L(0); PG8_BAR; PG8_MMA(0, 0, At, B0); PG8_MMA(0, 1, At, B1); PG8_BAR; PG8_SCHED;
            PG8_LDA(At, 1, 1); PG8_STAGE(PG8_SB(1, 0), b3, voffB); PG8_STAGE(PG8_SB(1, 1), b3 + hstepB, voffB); PG8_STAGE(PG8_SA(1, 0), a3, voffA);
            PG8_WAIT_V(8); PG8_WAIT_L(0); PG8_BAR; PG8_MMA(1, 0, At, B0); PG8_MMA(1, 1, At, B1); PG8_BAR; PG8_SCHED;
        }
        if (wr == 0) PG8_BAR;
        E(acc, cur, wr, wc, fr, fq);
        if (!has_next) break;
#pragma unroll
        for (int a = 0; a < 2; ++a)
#pragma unroll
            for (int b = 0; b < 2; ++b)
#pragma unroll
                for (int m = 0; m < 4; ++m)
#pragma unroll
                    for (int n = 0; n < 2; ++n) acc[a][b][m][n] = (f32x4){0.f, 0.f, 0.f, 0.f};
        cur = nxt; cA = nA; cB = nB; ++ui;
        if (wr == 1) PG8_BAR;
    }
    PG8_WAIT_V(0);
    PG8_BAR;
#undef PG8_SA
#undef PG8_SB
#undef PG8_STAGE
#undef PG8_LDA
#undef PG8_LDB
#undef PG8_MMA
#undef PG8_WAIT_V
#undef PG8_WAIT_L
#undef PG8_BAR
#undef PG8_SCHED
}
}

namespace att3 {
using bf16 = __hip_bfloat16;
using bf16x8 = __attribute__((ext_vector_type(8))) short;
using s16x4  = __attribute__((ext_vector_type(4))) short;
using f32x16 = __attribute__((ext_vector_type(16))) float;
using u32x4  = __attribute__((ext_vector_type(4))) unsigned;
typedef __attribute__((address_space(3))) unsigned char* ldsp_t;
typedef __attribute__((address_space(3))) const char* ldsc_t;
typedef short v4i16_t __attribute__((ext_vector_type(4)));
constexpr int   LD = 6144;
constexpr float SCALE = 0.088388347648318440f;
constexpr float THR = 8.f;
constexpr int STAGE = 65536, V_OFF = 32768;
#define SBAR() __builtin_amdgcn_sched_barrier(0)
__device__ __forceinline__ int crow(int r, int hi) { return (r & 3) + 8 * (r >> 2) + 4 * hi; }
__device__ __forceinline__ unsigned cvtpk(float lo, float hi) { unsigned r; asm volatile("v_cvt_pk_bf16_f32 %0, %1, %2" : "=v"(r) : "v"(lo), "v"(hi)); return r; }
__device__ __forceinline__ s16x4 vtr(ldsc_t p) { return __builtin_bit_cast(s16x4, __builtin_amdgcn_ds_read_tr16_b64_v4i16((__attribute__((address_space(3))) v4i16_t*)p)); }

template <class Hook> __device__ __forceinline__ void qk_sub(f32x16& p, ldsc_t k0, ldsc_t k1, ldsc_t k2, ldsc_t k3, int kd, const bf16x8* qr, const Hook& hook) {
#define KF(a, o) (*(const __attribute__((address_space(3))) bf16x8*)((a) + (o)))
  SBAR();
  bf16x8 f0 = KF(k0, 0), f1 = KF(k1, 0), f2 = KF(k2, 0), f3 = KF(k3, 0); SBAR();
  p = __builtin_amdgcn_mfma_f32_32x32x16_bf16(f0, qr[0], f32x16{}, 0, 0, 0); f0 = KF(k0 + kd, 0); SBAR();
  p = __builtin_amdgcn_mfma_f32_32x32x16_bf16(f1, qr[1], p, 0, 0, 0); f1 = KF(k1 + kd, 0); hook(0); SBAR();
  p = __builtin_amdgcn_mfma_f32_32x32x16_bf16(f2, qr[2], p, 0, 0, 0); f2 = KF(k2 + kd, 0); SBAR();
  p = __builtin_amdgcn_mfma_f32_32x32x16_bf16(f3, qr[3], p, 0, 0, 0); f3 = KF(k3 + kd, 0); hook(1); SBAR();
  p = __builtin_amdgcn_mfma_f32_32x32x16_bf16(f0, qr[4], p, 0, 0, 0); SBAR();
  p = __builtin_amdgcn_mfma_f32_32x32x16_bf16(f1, qr[5], p, 0, 0, 0); hook(2); SBAR();
  p = __builtin_amdgcn_mfma_f32_32x32x16_bf16(f2, qr[6], p, 0, 0, 0); SBAR();
  p = __builtin_amdgcn_mfma_f32_32x32x16_bf16(f3, qr[7], p, 0, 0, 0); hook(3); SBAR();
#undef KF
}
__device__ __forceinline__ int v_rd_base(int lane) { return ((lane & 3) << 3) | (((lane >> 2) & 3) << 6) | (((lane >> 4) & 1) << 5) | (((lane >> 5) & 1) << 8); }
constexpr int v_rd_off(int d0, int ks, int half) { return d0 * 512 + ks * 8192 + half * 4096; }
struct VG { s16x4 l0, h0, l1, h1; };
template <int D0, int S> __device__ __forceinline__ VG vload(ldsc_t vb) { VG g; g.l0 = vtr(vb + v_rd_off(D0, 2 * S, 0)); g.h0 = vtr(vb + v_rd_off(D0, 2 * S, 1)); g.l1 = vtr(vb + v_rd_off(D0, 2 * S + 1, 0)); g.h1 = vtr(vb + v_rd_off(D0, 2 * S + 1, 1)); return g; }
#define PK(L, H) (bf16x8){L[0], L[1], L[2], L[3], H[0], H[1], H[2], H[3]}
__device__ __forceinline__ void vmma(f32x16& od, const VG& g, bf16x8 pa0, bf16x8 pa1) {
  od = __builtin_amdgcn_mfma_f32_32x32x16_bf16(pa0, PK(g.l0, g.h0), od, 0, 0, 0);
  od = __builtin_amdgcn_mfma_f32_32x32x16_bf16(pa1, PK(g.l1, g.h1), od, 0, 0, 0);
}
#undef PK
__device__ __forceinline__ void softmax_sub(f32x16& p, float& m_reg, float& l_reg, bf16x8& pa0, bf16x8& pa1, f32x16 (&o)[8], float* al_l, int r32, int hi, int dj, const float* tab, float cL, float cR) {
  constexpr float C = SCALE * 1.4426950408889634f;
  float cb;
  if (dj <= -159) cb = cL;
  else if (dj >= 159) cb = cR;
  else { cb = 0.f; const int ib = dj - r32 + 4 * hi + 128;
#pragma unroll
    for (int r = 0; r < 16; ++r) { const int i0 = ib + (r & 3) + 8 * (r >> 2); p[r] += tab[min(max(i0, 0), 256)]; } }
  float pmax = p[0];
#pragma unroll
  for (int r = 1; r < 16; ++r) pmax = fmaxf(pmax, p[r]);
  { auto rr = __builtin_amdgcn_permlane32_swap(__float_as_uint(pmax), __float_as_uint(pmax), false, false);
    pmax = fmaxf(__uint_as_float(rr[0]), __uint_as_float(rr[1])) + cb; }
  float mn, alpha;
  if (__builtin_expect(__all(pmax - m_reg <= THR / SCALE), 1)) { mn = m_reg; alpha = 1.f; }
  else { mn = fmaxf(m_reg, pmax); alpha = __builtin_amdgcn_exp2f((m_reg - mn) * C); m_reg = mn;
    if (hi == 0) al_l[r32] = alpha; asm volatile("s_waitcnt lgkmcnt(0)" ::: "memory");
#pragma unroll
    for (int d = 0; d < 8; ++d)
#pragma unroll
      for (int r = 0; r < 16; ++r) o[d][r] *= al_l[crow(r, hi)]; }
  const float mnC = (cb - mn) * C;
  float ps = 0;
#pragma unroll
  for (int r = 0; r < 16; ++r) { p[r] = __builtin_amdgcn_exp2f(fmaf(p[r], C, mnC)); ps += p[r]; }
  { auto rr = __builtin_amdgcn_permlane32_swap(__float_as_uint(ps), __float_as_uint(ps), false, false);
    ps = __uint_as_float(rr[0]) + __uint_as_float(rr[1]); }
  l_reg = l_reg * alpha + ps;
#define PK4(P, BASE, OUT) do { unsigned a0 = cvtpk(P[BASE + 0], P[BASE + 1]), a1 = cvtpk(P[BASE + 2], P[BASE + 3]);   \
    unsigned b0 = cvtpk(P[BASE + 4], P[BASE + 5]), b1 = cvtpk(P[BASE + 6], P[BASE + 7]);                              \
    auto r0 = __builtin_amdgcn_permlane32_swap(a0, b0, false, false); auto r1 = __builtin_amdgcn_permlane32_swap(a1, b1, false, false); \
    u32x4 w = {r0[0], r1[0], r0[1], r1[1]}; OUT = *reinterpret_cast<bf16x8*>(&w); } while (0)
  PK4(p, 0, pa0); PK4(p, 8, pa1);
#undef PK4
}
template <int S, class Hook, class Dma> __device__ __forceinline__ void sub_step(f32x16 (&o)[8], ldsc_t k0, ldsc_t k1, ldsc_t k2, ldsc_t k3, int kd, ldsc_t vb, const bf16x8* qr, float& m_reg, float& l_reg, float* al_l,
                                                           int r32, int hi, int dj, const float* tab, float cL, float cR, const Hook& hook, const Dma& dma) {
  f32x16 p; bf16x8 pa0, pa1;
  qk_sub(p, k0 + S * 8192, k1 + S * 8192, k2 + S * 8192, k3 + S * 8192, kd, qr, hook);
  VG g0 = vload<0, S>(vb), g1 = vload<1, S>(vb);
  softmax_sub(p, m_reg, l_reg, pa0, pa1, o, al_l, r32, hi, dj, tab, cL, cR);
  SBAR(); __builtin_amdgcn_s_setprio(1);
  vmma(o[0], g0, pa0, pa1); dma(0); SBAR(); g0 = vload<2, S>(vb); SBAR();
  vmma(o[1], g1, pa0, pa1); dma(1); SBAR(); g1 = vload<3, S>(vb); SBAR();
  vmma(o[2], g0, pa0, pa1); dma(2); SBAR(); g0 = vload<4, S>(vb); SBAR();
  vmma(o[3], g1, pa0, pa1); dma(3); SBAR(); g1 = vload<5, S>(vb); SBAR();
  vmma(o[4], g0, pa0, pa1); SBAR(); g0 = vload<6, S>(vb); SBAR();
  vmma(o[5], g1, pa0, pa1); SBAR(); g1 = vload<7, S>(vb); SBAR();
  vmma(o[6], g0, pa0, pa1); SBAR(); vmma(o[7], g1, pa0, pa1); __builtin_amdgcn_s_setprio(0); SBAR();
}

__device__ __forceinline__ void attn_unit(const bf16* __restrict__ qkvb, int seq, int q0, int h, ldsp_t ldsb, float* wsc, const float* tab, float lam) {
  int tid_ = threadIdx.x; asm volatile("" : "+v"(tid_));
  const int tid = tid_, wid = __builtin_amdgcn_readfirstlane(tid >> 6), lane = tid & 63, r32 = lane & 31, hi = lane >> 5, mapw = wid >> 2, rg = wid & 3;
  float* ws = wsc + wid * 64; float* li_l = ws; float* al_l = ws + 32;
  float m_reg = -1e30f, l_reg = 0; bf16x8 qr[8]; f32x16 o[8];
#pragma unroll
  for (int d = 0; d < 8; ++d) o[d] = f32x16{};
  const int q0w = q0 + rg * 32;
  const bf16* Qw = qkvb + (long)(q0w + r32) * LD + h * 256 + mapw * 128 + hi * 8;
#pragma unroll
  for (int d0 = 0; d0 < 8; ++d0) qr[d0] = *reinterpret_cast<const bf16x8*>(Qw + d0 * 16);
  unsigned koff0, voff0;
  { const int row = 4 * wid + (lane >> 4), c = (lane & 15) ^ (row & 15); koff0 = (unsigned)(row * LD + 2048 + h * 256 + c * 8) * 2u; }
  { const int subt = 2 * wid + (lane >> 5), kk = ((subt >> 3) << 3) | ((lane & 31) >> 2), key = (kk & ~0xC) | ((kk & 4) << 1) | ((kk & 8) >> 1), col = (subt & 7) * 32 + 8 * (lane & 3);
    voff0 = (unsigned)(key * LD + 4096 + h * 256 + col) * 2u; }
  const char* kvb = (const char*)qkvb;
  const long tstep = 64L * LD * 2;
#define DMA_K1(g_, b, i_) __builtin_amdgcn_global_load_lds((const unsigned*)((g_) + (((i_) & 1) * 32 * LD * 2 + ((i_) >> 1) * 256) + koff0), (__attribute__((address_space(3))) unsigned*)(ldsb + (b) * STAGE + (wid + 8 * (i_)) * 1024), 16, 0, 0)
#define DMA_V1(g_, b, i_) __builtin_amdgcn_global_load_lds((const unsigned*)((g_) + ((i_) * 16 * LD * 2) + voff0), (__attribute__((address_space(3))) unsigned*)(ldsb + (b) * STAGE + V_OFF + (wid + 8 * (i_)) * 1024), 16, 0, 0)
  const int NT = seq / 64;
  const float cL = __int_as_float(__builtin_amdgcn_readfirstlane(__float_as_int(tab[0]))), cR = __int_as_float(__builtin_amdgcn_readfirstlane(__float_as_int(tab[256])));
  ldsc_t kp[4];
#pragma unroll
  for (int d = 0; d < 4; ++d) kp[d] = (ldsc_t)ldsb + (mapw * 16384 + r32 * 256 + ((d * 32 + hi * 16) ^ ((r32 & 15) << 4)));
  const int kd = (r32 & 8) ? -128 : 128;
  const ldsc_t vp = (ldsc_t)ldsb + (V_OFF + v_rd_base(lane));
  { _Pragma("unroll") for (int i = 0; i < 4; ++i) { DMA_K1(kvb, 0, i); DMA_V1(kvb, 0, i); } }
  asm volatile("s_waitcnt vmcnt(0)" : "+v"(qr[0]), "+v"(qr[1]), "+v"(qr[2]), "+v"(qr[3]), "+v"(qr[4]), "+v"(qr[5]), "+v"(qr[6]), "+v"(qr[7]) :: "memory");
  for (int j = 0; j < NT; ++j) {
    const int bo = (j & 1) * STAGE; const int bn = (j + 1) & 1; const bool more = j + 1 < NT;
    const char* gn = kvb + (long)(j + 1) * tstep;
    asm volatile("s_waitcnt vmcnt(0)" ::: "memory");
    asm volatile("" ::: "memory"); __builtin_amdgcn_s_barrier(); asm volatile("" ::: "memory");
    sub_step<0>(o, kp[0] + bo, kp[1] + bo, kp[2] + bo, kp[3] + bo, kd, vp + bo, qr, m_reg, l_reg, al_l, r32, hi, 64 * j - q0w, tab, cL, cR, [&](int i) { if (more) DMA_K1(gn, bn, i); }, [&](int i) { if (more) DMA_V1(gn, bn, i); });
    sub_step<1>(o, kp[0] + bo, kp[1] + bo, kp[2] + bo, kp[3] + bo, kd, vp + bo, qr, m_reg, l_reg, al_l, r32, hi, 64 * j + 32 - q0w, tab, cL, cR, [](int) {}, [](int) {});
  }
  if (hi == 0) li_l[r32] = l_reg; asm volatile("s_waitcnt lgkmcnt(0)" ::: "memory");
  float rli[16];
#pragma unroll
  for (int r = 0; r < 16; ++r) rli[r] = __builtin_amdgcn_rcpf(li_l[crow(r, hi)]);
  typedef __attribute__((address_space(3))) float* ldsf_t;
  const ldsf_t df = (ldsf_t)ldsb + (rg * 32 + 4 * hi) * 256;
  asm volatile("s_waitcnt lgkmcnt(0)" ::: "memory"); __builtin_amdgcn_s_barrier(); asm volatile("" ::: "memory");
  if (mapw) {
#pragma unroll
    for (int r = 0; r < 16; ++r)
#pragma unroll
      for (int d = 0; d < 8; ++d) df[((r & 3) + 8 * (r >> 2)) * 256 + ((d * 32 + r32) ^ ((d >> 1) << 2) ^ ((r & 3) << 4))] = -lam * o[d][r] * rli[r];
  }
  asm volatile("s_waitcnt lgkmcnt(0)" ::: "memory"); __builtin_amdgcn_s_barrier(); asm volatile("" ::: "memory");
  if (!mapw) {
#pragma unroll
    for (int r = 0; r < 16; ++r)
#pragma unroll
      for (int d = 0; d < 8; ++d) { const ldsf_t p_ = df + (((r & 3) + 8 * (r >> 2)) * 256 + ((d * 32 + r32) ^ ((d >> 1) << 2) ^ ((r & 3) << 4))); *p_ = *p_ + o[d][r] * rli[r]; }
  }
#undef DMA_K1
#undef DMA_V1
}
#undef SBAR
}

constexpr int NWAVES = 8;
constexpr int DM = 2048, TOK = 65536, TC = 16384, NCHUNK = 4, DEPTH = 2;
constexpr int INW = 11264, QKVW = 6144, GATEW = 4096, DFF = 5632, NIN = 10240;
constexpr float LN_EPS = 1e-5f;
constexpr float ALPHA = 1.4142135623730951f;

constexpr size_t MiB = 1u << 20;
constexpr size_t WS_CTL = 0, CTL_ZERO_BYTES = 32768;
constexpr size_t WS_DFT1 = 1 * MiB;
constexpr size_t WS_M2P = 2 * MiB;
constexpr size_t WS_M2S = 4 * MiB;
constexpr size_t WS_W = 12 * MiB;
constexpr size_t W_IN = 0, W_F = 40 * MiB, W_A = 48 * MiB, W_F2 = 56 * MiB, W_O = 60 * MiB, W_GU = 68 * MiB, W_D = 112 * MiB, W_LAYER = 134 * MiB;
constexpr size_t WS_XB = WS_W + 2 * W_LAYER;
constexpr size_t WS_QKV = WS_XB + 64 * MiB;
constexpr size_t WS_GATE = WS_QKV + 192 * MiB;
constexpr size_t WS_Z = WS_GATE + 128 * MiB;
constexpr size_t WS_G2 = WS_Z + 64 * MiB;
constexpr size_t WS_O = WS_G2 + 64 * MiB;
constexpr size_t WS_MUST = WS_O + 64 * MiB;
constexpr size_t WS_RB = WS_MUST + 1 * MiB;
constexpr size_t WS_C1P = WS_RB + 64 * MiB;
constexpr size_t WS_C2P = WS_C1P + 3 * MiB;
constexpr size_t WS_C12 = WS_C2P + 3 * MiB;
constexpr size_t WS_STATP = WS_C12 + 1 * MiB;
constexpr size_t WS_END = WS_STATP + 1 * MiB;
constexpr int CW_BAR = 4096;

constexpr int RING_OFF = 0, RING_BYTES = 131072;
constexpr int LDSCTL_OFF = RING_BYTES, MISC_OFF = LDSCTL_OFF + 320;
constexpr int WSC_OFF = RING_BYTES + 512;
constexpr int TAB_OFF = WSC_OFF + 2048;
constexpr int LRED_OFF = TAB_OFF + 8320;
constexpr int LDS_BYTES = 151552;

#define GAS __attribute__((address_space(1)))
#define LAS __attribute__((address_space(3)))
typedef unsigned short bf16;
typedef unsigned v4u __attribute__((ext_vector_type(4)));
typedef unsigned v2u __attribute__((ext_vector_type(2)));
typedef float f32x4 __attribute__((ext_vector_type(4)));
typedef GAS unsigned gu32;
#define RLX_AGENT __ATOMIC_RELAXED, __HIP_MEMORY_SCOPE_AGENT
#define LDS_WAIT() asm volatile("s_waitcnt lgkmcnt(0)" ::: "memory")
#define VM_WAIT() asm volatile("s_waitcnt vmcnt(0)" ::: "memory")
__device__ __forceinline__ unsigned f2bf(float f) { unsigned u = __builtin_bit_cast(unsigned, f); return (u + 0x7fffu + ((u >> 16) & 1u)) >> 16; }
__device__ __forceinline__ unsigned pk2(float lo, float hi) { return f2bf(lo) | (f2bf(hi) << 16); }

#define XB_TMO      128
#define XB_XCNT(j)  (256  + 64 * (j))
#define XB_XSUB(j)  (1280 + 64 * (j))
#define XB_XGEN(j)  (2304 + 64 * (j))
#define XB_TOP      3328
#define XB_TOPGEN   3392
#define XCD_BAR_WORDS 3456
#define XB_SPIN_CAP (1u << 21)

__device__ __forceinline__ unsigned xb_ld(unsigned* p)              { return __hip_atomic_load(p, __ATOMIC_RELAXED, __HIP_MEMORY_SCOPE_AGENT); }
__device__ __forceinline__ unsigned xb_add(unsigned* p, unsigned v) { return __hip_atomic_fetch_add(p, v, __ATOMIC_RELAXED, __HIP_MEMORY_SCOPE_AGENT); }
__device__ __forceinline__ unsigned xb_xcc_id() { return (unsigned)__builtin_amdgcn_s_getreg((3 << 11) | 20) & 0xFu; }
#define XB_SPIN(cond, bar) do { unsigned _sp = 0; while (cond) { __builtin_amdgcn_s_sleep(1); \
    if ((++_sp & 255u) == 0u) { if (xb_ld(&(bar)[XB_TMO])) break; if (_sp > XB_SPIN_CAP) { atomicAdd(&(bar)[XB_TMO], 1u); break; } } } } while (0)

struct XcdBarrier {
    unsigned* bar; unsigned x;
    volatile LAS unsigned* st;
};
__device__ __forceinline__ XcdBarrier xcd_barrier_post(unsigned* bar, volatile LAS unsigned* st) {
    XcdBarrier b; b.bar = bar; b.x = xb_xcc_id(); b.st = st;
    if (threadIdx.x == 0) (void)xb_add(&bar[XB_XCNT(b.x)], 1u);
    return b;
}
__device__ __forceinline__ void xcd_barrier_complete(unsigned* bar, unsigned x, unsigned& nloc, unsigned& nx) {
    const unsigned G = gridDim.x * gridDim.y * gridDim.z;
    unsigned sum, cnt, mine, sp = 0u;
    for (;;) {
        sum = 0u; cnt = 0u; mine = 0u;
#pragma unroll
        for (unsigned j = 0; j < 16; ++j) { const unsigned c = xb_ld(&bar[XB_XCNT(j)]); sum += c; cnt += (c > 0u) ? 1u : 0u; mine = (j == x) ? c : mine; }
        if (sum == G) break;
        __builtin_amdgcn_s_sleep(1);
        if ((++sp & 255u) == 0u) { if (xb_ld(&bar[XB_TMO])) break; if (sp > XB_SPIN_CAP) { atomicAdd(&bar[XB_TMO], 1u); break; } }
    }
    nloc = mine > 0u ? mine : 1u; nx = cnt > 0u ? cnt : 1u;
}
__device__ __forceinline__ void xcd_barrier(const XcdBarrier& b) {
    asm volatile("s_waitcnt vmcnt(0)" ::: "memory");
    __syncthreads();
    unsigned t0_ = threadIdx.x; asm volatile("" : "+v"(t0_));
    if (t0_ == 0) {
        unsigned* bar = b.bar;
        __builtin_amdgcn_s_waitcnt(0);
        unsigned nloc = b.st[0], nx = b.st[1];
        if (nloc == 0u) { xcd_barrier_complete(bar, b.x, nloc, nx); b.st[0] = nloc; b.st[1] = nx; }
        const unsigned old = xb_add(&bar[XB_XSUB(b.x)], 1u);
        const unsigned gen = old / nloc;
        if (old + 1u == (gen + 1u) * nloc) {
            __builtin_amdgcn_fence(__ATOMIC_RELEASE, "agent");
            asm volatile("s_waitcnt vmcnt(0)" ::: "memory");
            const unsigned og = xb_add(&bar[XB_TOP], 1u);
            const unsigned tg = og / nx;
            if (og + 1u == (tg + 1u) * nx) xb_add(&bar[XB_TOPGEN], 1u);
            else XB_SPIN(xb_ld(&bar[XB_TOPGEN]) == tg, bar);
            __builtin_amdgcn_fence(__ATOMIC_ACQUIRE, "agent");
            xb_add(&bar[XB_XGEN(b.x)], 1u);
            asm volatile("s_waitcnt vmcnt(0)" ::: "memory");
        } else {
            XB_SPIN(xb_ld(&bar[XB_XGEN(b.x)]) == gen, bar);
            __builtin_amdgcn_fence(__ATOMIC_ACQUIRE, "agent");
            asm volatile("s_waitcnt vmcnt(0)" ::: "memory");
        }
    }
    __syncthreads();
}

struct Frame {
    LAS unsigned char* lds;
    int tid, lane, wave;
    int vcu, G;
};
__device__ __forceinline__ float wave_sum(float v, int lane) {
#pragma unroll
    for (int o = 1; o < 64; o <<= 1) v += __uint_as_float((unsigned)__builtin_amdgcn_ds_bpermute((lane ^ o) << 2, (int)__float_as_uint(v)));
    return v;
}
#define PHASE_TID() do { int t_ = threadIdx.x; asm volatile("" : "+v"(t_)); F.tid = t_; F.lane = t_ & 63; F.wave = __builtin_amdgcn_readfirstlane(t_ >> 6); asm volatile("" : "+s"(F.vcu), "+s"(F.G)); } while (0)
__device__ __forceinline__ void p0_transpose_item(const float* W, size_t ldsrc, int srccol0, int k0, bf16* WT, size_t Kd, int dstrow0, LAS float* scr, int lane, float scl = 1.0f) {
#pragma unroll 8
    for (int i = 0; i < 32; ++i) { const int kk = 2 * i + (lane >> 5); scr[kk * 33 + (lane & 31)] = W[(size_t)(k0 + kk) * ldsrc + srccol0 + (lane & 31)] * scl; }
    LDS_WAIT(); asm volatile("" ::: "memory");
    const int c = lane & 7;
#pragma unroll
    for (int j = 0; j < 4; ++j) { const int n = (lane >> 3) + 8 * j; const LAS float* s = scr + (8 * c) * 33 + n;
        v4u o; o.x = pk2(s[0 * 33], s[1 * 33]); o.y = pk2(s[2 * 33], s[3 * 33]); o.z = pk2(s[4 * 33], s[5 * 33]); o.w = pk2(s[6 * 33], s[7 * 33]);
        *(GAS v4u*)(WT + (size_t)(dstrow0 + n) * Kd + k0 + 8 * c) = o; }
    LDS_WAIT(); asm volatile("" ::: "memory");
}
__device__ __forceinline__ void p0_transpose_item_g(const float* W, size_t ldsrc, int srccol0, int k0, bf16* WT, size_t Kd, int dstrow0, LAS float* scr, int lane, const float* gam, const float* bet, float* c1p, float* c2p) {
    float s1 = 0.f, s2 = 0.f;
#pragma unroll 8
    for (int i = 0; i < 32; ++i) { const int kk = 2 * i + (lane >> 5); const float w = W[(size_t)(k0 + kk) * ldsrc + srccol0 + (lane & 31)];
        const float wr = __uint_as_float(f2bf(w * gam[k0 + kk]) << 16); scr[kk * 33 + (lane & 31)] = wr; s1 += wr; s2 += bet[k0 + kk] * w; }
    s1 += __uint_as_float((unsigned)__builtin_amdgcn_ds_bpermute((lane ^ 32) << 2, (int)__float_as_uint(s1)));
    s2 += __uint_as_float((unsigned)__builtin_amdgcn_ds_bpermute((lane ^ 32) << 2, (int)__float_as_uint(s2)));
    if (lane < 32) { c1p[dstrow0 + lane] = s1; c2p[dstrow0 + lane] = s2; }
    LDS_WAIT(); asm volatile("" ::: "memory");
    const int c = lane & 7;
#pragma unroll
    for (int j = 0; j < 4; ++j) { const int n = (lane >> 3) + 8 * j; const LAS float* s = scr + (8 * c) * 33 + n;
        v4u o; o.x = pk2(s[0 * 33], s[1 * 33]); o.y = pk2(s[2 * 33], s[3 * 33]); o.z = pk2(s[4 * 33], s[5 * 33]); o.w = pk2(s[6 * 33], s[7 * 33]);
        *(GAS v4u*)(WT + (size_t)(dstrow0 + n) * Kd + k0 + 8 * c) = o; }
    LDS_WAIT(); asm volatile("" ::: "memory");
}
__device__ __forceinline__ void ln_rows(const Frame& F, const float* src, float* dstf, bf16* dstb, float* must, const float* gam, const float* bet, int nrows, bool poison) {
    const int gw = F.vcu * NWAVES + F.wave, NGW = F.G * NWAVES;
    f32x4 vn[8];
    if (gw < nrows) { const GAS f32x4* xr = (const GAS f32x4*)(src + (size_t)gw * DM) + F.lane;
#pragma unroll
        for (int j = 0; j < 8; ++j) vn[j] = xr[64 * j]; }
    for (int m = gw; m < nrows; m += NGW) {
        f32x4 v[8]; float s = 0.f;
#pragma unroll
        for (int j = 0; j < 8; ++j) { v[j] = vn[j]; s += (v[j].x + v[j].y) + (v[j].z + v[j].w); }
        if (m + NGW < nrows) { const GAS f32x4* xr = (const GAS f32x4*)(src + (size_t)(m + NGW) * DM) + F.lane;
#pragma unroll
            for (int j = 0; j < 8; ++j) vn[j] = xr[64 * j]; }
        const float mean = wave_sum(s, F.lane) * (1.f / DM); float s2 = 0.f;
#pragma unroll
        for (int j = 0; j < 8; ++j) { v[j] = v[j] - mean; s2 += (v[j].x * v[j].x + v[j].y * v[j].y) + (v[j].z * v[j].z + v[j].w * v[j].w); }
        const float rstd = 1.f / sqrtf(wave_sum(s2, F.lane) * (1.f / DM) + LN_EPS);
        if (must && F.lane == 0) { float2 o2; o2.x = mean; o2.y = rstd; *(float2*)(must + (size_t)m * 2) = o2; }
        GAS f32x4* of = (GAS f32x4*)(dstf + (size_t)m * DM) + F.lane;
#pragma unroll
        for (int j = 0; j < 8; ++j) { const f32x4 g = ((const GAS f32x4*)gam)[64 * j + F.lane], b = ((const GAS f32x4*)bet)[64 * j + F.lane];
            f32x4 o = v[j] * rstd * g + b;
            if (poison) { const float q = __builtin_nanf(""); o = (f32x4){q, q, q, q}; }
            if (dstf) of[64 * j] = o;
            if (dstb) { v2u w; w.x = pk2(o.x, o.y); w.y = pk2(o.z, o.w); ((GAS v2u*)(dstb + (size_t)m * DM))[64 * j + F.lane] = w; } }
    }
}
__device__ __forceinline__ void ln_rows_b(const Frame& F, const bf16* src, float* dstf, bf16* dstb, float* must, const float* gam, const float* bet, int nrows, bool poison) {
    const int gw = F.vcu * NWAVES + F.wave, NGW = F.G * NWAVES;
    v4u wn[4];
    if (gw < nrows) { const GAS v4u* xr = (const GAS v4u*)(src + (size_t)gw * DM) + F.lane;
#pragma unroll
        for (int j = 0; j < 4; ++j) wn[j] = xr[64 * j]; }
    for (int m = gw; m < nrows; m += NGW) {
        v4u wc[4];
#pragma unroll
        for (int j = 0; j < 4; ++j) wc[j] = wn[j];
        if (m + NGW < nrows) { const GAS v4u* xr = (const GAS v4u*)(src + (size_t)(m + NGW) * DM) + F.lane;
#pragma unroll
            for (int j = 0; j < 4; ++j) wn[j] = xr[64 * j]; }
        float v[4][8]; float s = 0.f;
#pragma unroll
        for (int j = 0; j < 4; ++j) { const v4u w = wc[j];
            v[j][0] = __uint_as_float(w.x << 16); v[j][1] = __uint_as_float(w.x & 0xffff0000u); v[j][2] = __uint_as_float(w.y << 16); v[j][3] = __uint_as_float(w.y & 0xffff0000u);
            v[j][4] = __uint_as_float(w.z << 16); v[j][5] = __uint_as_float(w.z & 0xffff0000u); v[j][6] = __uint_as_float(w.w << 16); v[j][7] = __uint_as_float(w.w & 0xffff0000u);
#pragma unroll
            for (int e = 0; e < 8; ++e) s += v[j][e]; }
        const float mean = wave_sum(s, F.lane) * (1.f / DM); float s2 = 0.f;
#pragma unroll
        for (int j = 0; j < 4; ++j)
#pragma unroll
            for (int e = 0; e < 8; ++e) { v[j][e] -= mean; s2 += v[j][e] * v[j][e]; }
        const float rstd = 1.f / sqrtf(wave_sum(s2, F.lane) * (1.f / DM) + LN_EPS);
        if (must && F.lane == 0) { float2 o2; o2.x = mean; o2.y = rstd; *(float2*)(must + (size_t)m * 2) = o2; }
#pragma unroll
        for (int j = 0; j < 4; ++j) { const int c0 = (64 * j + F.lane) * 8;
            const f32x4 g0 = *(const GAS f32x4*)(gam + c0), g1 = *(const GAS f32x4*)(gam + c0 + 4), b0 = *(const GAS f32x4*)(bet + c0), b1 = *(const GAS f32x4*)(bet + c0 + 4);
            f32x4 o0 = (f32x4){v[j][0], v[j][1], v[j][2], v[j][3]} * rstd * g0 + b0, o1 = (f32x4){v[j][4], v[j][5], v[j][6], v[j][7]} * rstd * g1 + b1;
            if (poison) { const float q = __builtin_nanf(""); o0 = (f32x4){q, q, q, q}; o1 = o0; }
            if (dstf) { *(GAS f32x4*)(dstf + (size_t)m * DM + c0) = o0; *(GAS f32x4*)(dstf + (size_t)m * DM + c0 + 4) = o1; }
            if (dstb) { v4u w; w.x = pk2(o0.x, o0.y); w.y = pk2(o0.z, o0.w); w.z = pk2(o1.x, o1.y); w.w = pk2(o1.z, o1.w); *(GAS v4u*)(dstb + (size_t)m * DM + c0) = w; } }
    }
}
__device__ __forceinline__ int rel_bucket(int rel) {
    const int ret = rel > 0 ? 16 : 0; const int n = rel < 0 ? -rel : rel; int v;
    if (n < 8) v = n; else { const int large = 8 + ((31 - __clz(n * n)) - 6); v = large < 15 ? large : 15; }
    return ret + v;
}

struct Args { const float* in[18]; float* out; unsigned char* ws; int ph_lo, ph_hi; unsigned char* wsp[17]; unsigned char* pad_; };
typedef const void* __attribute__((address_space(4))) const kslot_t;
__device__ __forceinline__ const void* karg(int i) { asm volatile("" : "+s"(i)); return ((kslot_t*)__builtin_amdgcn_kernarg_segment_ptr())[i]; }
#define KIN(i) ((const float*)karg(i))
#define KOUT ((float*)karg(18))
#define KWS ((unsigned char*)karg(19))
constexpr int PH_PER_IT = 10, N_IT = NCHUNK * DEPTH, PH_TOTAL = 1 + N_IT * PH_PER_IT + 1;

__global__ void __launch_bounds__(NWAVES * 64, 2) fwd_kernel(Args args) {
    extern __shared__ __attribute__((aligned(16))) unsigned char lds[];
    Frame F;
    F.lds = (LAS unsigned char*)lds;
    volatile LAS unsigned* MISC = (volatile LAS unsigned*)(F.lds + MISC_OFF);
    F.tid = threadIdx.x; F.lane = F.tid & 63; F.wave = __builtin_amdgcn_readfirstlane(F.tid >> 6);
    F.G = gridDim.x; { const int bx = blockIdx.x; F.vcu = (F.G % 8 == 0) ? (bx % 8) * (F.G / 8) + bx / 8 : bx; }
    gu32* ctl = (gu32*)(args.ws + WS_CTL);
    for (int u = F.tid; u < (WSC_OFF - LDSCTL_OFF) / 4; u += NWAVES * 64) ((LAS unsigned*)(F.lds + LDSCTL_OFF))[u] = 0u;
    { LAS float* tabS = (LAS float*)(F.lds + TAB_OFF);
      for (int e = F.tid; e < 8 * 257; e += NWAVES * 64) { const int h = e / 257, i = e % 257; tabS[h * 260 + i] = args.in[2][rel_bucket(i - 128) * 8 + h] * 11.313708498984761f; } }
    __syncthreads();
    XcdBarrier bar; bar.bar = (unsigned*)(ctl + CW_BAR); bar.x = 0; bar.st = nullptr;
    if (!MK_PER_PHASE) bar = xcd_barrier_post((unsigned*)(ctl + CW_BAR), MISC + 8);
    const int lo = MK_PER_PHASE ? args.ph_lo : 0, hi = MK_PER_PHASE ? args.ph_hi : PH_TOTAL;
#define IN(k) (lo <= (k) && (k) < hi)
#define SEAM(k) do { if ((k) + 1 < hi) { XcdBarrier bb_ = bar; asm volatile("" : "+s"(bb_.bar), "+s"(bb_.x)); xcd_barrier(bb_); } } while (0)

#define P_XB ((bf16*)karg(21))
#define P_QKV ((bf16*)karg(22))
#define P_GATE ((bf16*)karg(23))
#define P_ZT ((bf16*)karg(24))
#define P_MERGED ((bf16*)karg(24))
#define P_G2 ((bf16*)karg(25))
#define P_OB ((bf16*)karg(26))
#define P_YB ((bf16*)karg(21))
#define P_ACT ((bf16*)karg(22))
#define P_SCR ((float*)karg(21))
#define P_DFT1 ((bf16*)karg(27))
#define P_XC (KOUT + (size_t)c * TC * DM)
#define WL(off) ((const pg8::bf16_t*)((const unsigned char*)karg(30 + l) + (unsigned)(off)))
#define P_M2(lg) ((const pg8::bf16_t*)karg((lg) == 4 ? 28 : 29))
#define P_MUST ((float*)karg(32))
#define P_RB ((bf16*)karg(33))
#define P_C1P ((float*)karg(34))
#define P_C2P ((float*)karg(35))
#define P_C12 ((float*)karg(36))
#define P_STATP ((float*)karg(37))
    if (IN(0)) {
        PHASE_TID();
        const int gw = F.vcu * NWAVES + F.wave, NGW = F.G * NWAVES;
        {
            LAS float* scr = (LAS float*)(F.lds + RING_OFF + F.wave * 16384);
            constexpr int I_IN = 32 * 320, I_A = 32 * 64, I_F2 = 16 * 64, I_O = 32 * 64, I_GU = 32 * 352, I_D = 88 * 64;
            constexpr int I_LAYER = I_IN + I_A + I_F2 + I_O + I_GU + I_D;
            for (int it = gw; it < DEPTH * I_LAYER; it += NGW) {
                const int l = it / I_LAYER; int r = it % I_LAYER;
                unsigned char* wl = (unsigned char*)karg(30 + l);
                if (r < I_IN) { const int kb = r / 320, nb = r % 320, n0 = nb * 32; const int sc = n0 < QKVW ? n0 : n0 + 1024;
                    p0_transpose_item(KIN(5) + (size_t)l * DM * INW, INW, sc, kb * 64, (bf16*)(wl + W_IN), DM, n0, scr, F.lane, n0 < QKVW ? 1.0f : -1.4426950408889634f); continue; } r -= I_IN;
                if (r < I_A) { const int kb = r / 64, nb = r % 64; p0_transpose_item(KIN(9) + (size_t)l * DM * DM, DM, nb * 32, kb * 64, (bf16*)(wl + W_A), DM, nb * 32, scr, F.lane); continue; } r -= I_A;
                if (r < I_F2) { const int kb = r / 64, nb = r % 64; p0_transpose_item(KIN(10) + (size_t)l * 1024 * DM, DM, nb * 32, kb * 64, (bf16*)(wl + W_F2), 1024, nb * 32, scr, F.lane); continue; } r -= I_F2;
                if (r < I_O) { const int kb = r / 64, nb = r % 64; p0_transpose_item(KIN(11) + (size_t)l * DM * DM, DM, nb * 32, kb * 64, (bf16*)(wl + W_O), DM, nb * 32, scr, F.lane); continue; } r -= I_O;
                if (r < I_GU) { const int kb = r / 352, nb = r % 352, n0 = nb * 32, t = n0 >> 8, j = n0 & 255; const int sc = j < 128 ? 128 * t + j : DFF + 128 * t + (j - 128);
                    p0_transpose_item_g(KIN(14) + (size_t)l * DM * INW, INW, sc, kb * 64, (bf16*)(wl + W_GU), DM, n0, scr, F.lane, KIN(12) + (size_t)l * DM, KIN(13) + (size_t)l * DM,
                                        P_C1P + ((size_t)l * 32 + kb) * INW, P_C2P + ((size_t)l * 32 + kb) * INW); continue; } r -= I_GU;
                { const int kb = r / 64, nb = r % 64; p0_transpose_item(KIN(15) + (size_t)l * DFF * DM, DM, nb * 32, kb * 64, (bf16*)(wl + W_D), DFF, nb * 32, scr, F.lane); }
            }
        }
        __syncthreads();
        {
            const int part = F.wave >> 2, cb = F.wave & 3, r32 = F.lane & 31, hi = F.lane >> 5;
            LAS float* ctab = (LAS float*)(F.lds + RING_OFF); LAS float* stab = ctab + 128;
            if (F.tid < 128) { float sv, cv; sincospif((float)F.tid * (1.0f / 64.0f), &sv, &cv); ctab[F.tid] = cv * 0.08838834764831845f; stab[F.tid] = -sv * 0.08838834764831845f; }
            __syncthreads();
            const LAS float* tb = part ? stab : ctab;
            att3::bf16x8 th[8], tl[8];
#pragma unroll
            for (int s = 0; s < 8; ++s) { att3::u32x4 wh_, wl_;
#pragma unroll
                for (int e2 = 0; e2 < 4; ++e2) { unsigned hh[2], ll[2];
#pragma unroll
                    for (int q = 0; q < 2; ++q) { const int c = 16 * s + 8 * hi + 2 * e2 + q; const float t = tb[(c * (cb * 32 + r32)) & 127]; hh[q] = f2bf(t); ll[q] = f2bf(t - __uint_as_float(hh[q] << 16)); }
                    wh_[e2] = hh[0] | (hh[1] << 16); wl_[e2] = ll[0] | (ll[1] << 16); }
                th[s] = __builtin_bit_cast(att3::bf16x8, wh_); tl[s] = __builtin_bit_cast(att3::bf16x8, wl_); asm volatile("" : "+v"(th[s]), "+v"(tl[s])); }
            for (int item = F.vcu; item < DEPTH * 8 * 32; item += F.G) {
                const int l = item >> 8, g = (item >> 5) & 7, kb = item & 31, k0 = kb * 64;
                const float* src = KIN(5) + (size_t)l * DM * INW + (size_t)(k0 + r32) * INW + QKVW + g * 128 + 8 * hi;
                bf16* dst = (bf16*)((unsigned char*)karg(30 + l) + (unsigned)W_F) + k0 + r32;
#pragma unroll
                for (int nt = 0; nt < 2; ++nt) {
                    att3::f32x16 acc = {};
#pragma unroll
                    for (int sh = 0; sh < 2; ++sh) {
                        f32x4 w0[4], w1[4];
#pragma unroll
                        for (int s = 0; s < 4; ++s) { const GAS f32x4* p = (const GAS f32x4*)(src + (size_t)nt * 32 * INW + 16 * (sh * 4 + s)); w0[s] = p[0]; w1[s] = p[1]; }
                        __builtin_amdgcn_sched_barrier(0);
#pragma unroll
                        for (int s = 0; s < 4; ++s) { att3::u32x4 wh_, wl_;
#pragma unroll
                            for (int e2 = 0; e2 < 4; ++e2) { const float wa = e2 < 2 ? w0[s][2 * e2] : w1[s][2 * e2 - 4], wb = e2 < 2 ? w0[s][2 * e2 + 1] : w1[s][2 * e2 - 3];
                                const unsigned ha = f2bf(wa), hb = f2bf(wb); wh_[e2] = ha | (hb << 16); wl_[e2] = pk2(wa - __uint_as_float(ha << 16), wb - __uint_as_float(hb << 16)); }
                            const att3::bf16x8 wh = __builtin_bit_cast(att3::bf16x8, wh_), wl = __builtin_bit_cast(att3::bf16x8, wl_);
                            acc = __builtin_amdgcn_mfma_f32_32x32x16_bf16(th[sh * 4 + s], wh, acc, 0, 0, 0);
                            acc = __builtin_amdgcn_mfma_f32_32x32x16_bf16(th[sh * 4 + s], wl, acc, 0, 0, 0);
                            acc = __builtin_amdgcn_mfma_f32_32x32x16_bf16(tl[sh * 4 + s], wh, acc, 0, 0, 0); __builtin_amdgcn_sched_barrier(0); }
                    }
#pragma unroll
                    for (int r = 0; r < 16; ++r) { const int cp = cb * 32 + 4 * hi + (r & 3) + 8 * (r >> 2);
                        const bool ok = part ? (cp >= 1 && cp <= 63) : (cp <= 64); const int row = part ? 520 + g * 63 + cp - 1 : g * 65 + cp;
                        if (ok) dst[(size_t)row * DM + nt * 32] = (bf16)f2bf(acc[r]); if ((r & 3) == 3) __builtin_amdgcn_sched_barrier(0); }
                }
            }
        }
        {
            const int gt = F.vcu * (NWAVES * 64) + F.tid, NGT = F.G * NWAVES * 64;
            for (int e8 = gt; e8 < (256 * 256 + 8 * 256 * 512 + 32 * 256 * 512) / 8; e8 += NGT) {
                float v[8]; bf16* dst;
                if (e8 < 256 * 256 / 8) {
                    const int row = e8 >> 5, c0 = (e8 & 31) * 8, pp = row >> 7, k1 = row & 127;
#pragma unroll
                    for (int i = 0; i < 8; ++i) { const int col = c0 + i, p = col >> 7, s1 = col & 127; float sv, cv; sincospif((float)((k1 * s1) & 127) * (1.0f / 64.0f), &sv, &cv);
                        v[i] = (pp == p ? cv : (pp == 0 ? sv : -sv)) * 0.08838834764831845f; }
                    dst = P_DFT1 + (size_t)e8 * 8;
                } else {
                    int q = e8 - 256 * 256 / 8; int lgN2; bf16* base;
                    if (q < 8 * 256 * 512 / 8) { lgN2 = 4; base = (bf16*)karg(28); } else { q -= 8 * 256 * 512 / 8; lgN2 = 6; base = (bf16*)karg(29); }
                    const int N2 = 1 << lgN2, S = 128 << lgN2, gk = 256 >> lgN2;
                    const int gi = q >> 14, rem = q & 16383, m = rem >> 6, kk0 = (rem & 63) * 8;
                    const int k1l = m >> lgN2, k2 = m & (N2 - 1), k = gi * gk + k1l + 128 * k2;
                    const float sc = lgN2 == 4 ? 0.25f : 0.125f;
#pragma unroll
                    for (int i = 0; i < 8; ++i) { const int kk = kk0 + i, k1lp = kk >> (lgN2 + 1), pp = (kk >> lgN2) & 1, s2 = kk & (N2 - 1);
                        float sv, cv; sincospif((float)((s2 * k) & (S - 1)) * (2.0f / (float)S), &sv, &cv);
                        v[i] = (k1lp == k1l) ? (pp ? sv : cv) * sc : 0.f; }
                    dst = base + (size_t)q * 8;
                }
                v4u o; o.x = pk2(v[0], v[1]); o.y = pk2(v[2], v[3]); o.z = pk2(v[4], v[5]); o.w = pk2(v[6], v[7]);
                *(GAS v4u*)dst = o;
            }
        }
        if (!MK_PER_PHASE) ln_rows(F, KIN(0), nullptr, P_XB, P_MUST, KIN(3), KIN(4), TC, false);
        SEAM(0);
    }

    for (int it = 0; it < N_IT; ++it) {
        const int c = it >> 1, l = it & 1, P = 1 + it * PH_PER_IT;
        if (hi <= P || lo >= P + PH_PER_IT) continue;
        const int lgN2 = c < 2 ? 4 : 6, S = 128 << lgN2, Bc = TC / S;

        if (IN(P + 0)) {
            PHASE_TID();
            if (it == 0) {
                const int gt = F.vcu * (NWAVES * 64) + F.tid, NGT = F.G * NWAVES * 64;
                for (int e = gt; e < 2 * 2 * INW; e += NGT) { const int ll = e / (2 * INW), which = (e / INW) & 1, n = e % INW;
                    const float* p = (which ? P_C2P : P_C1P) + (size_t)ll * 32 * INW + n; float s = 0.f;
                    for (int kb = 0; kb < 32; ++kb) s += p[(size_t)kb * INW];
                    P_C12[((size_t)ll * 2 + which) * INW + n] = s; }
            }
            if (MK_PER_PHASE || it != 0) {
            if (l == 0) {
                const float* xin = c < 2 ? KIN(0) + (size_t)c * TC * DM : KIN(1) + (size_t)(c - 2) * TC * DM;
                ln_rows(F, xin, nullptr, P_XB, P_MUST, KIN(3), KIN(4), TC, false);
                if (c > 0) ln_rows_b(F, P_RB, KOUT + (size_t)(c - 1) * TC * DM, nullptr, nullptr, KIN(16) + DM, KIN(17) + DM, TC, false);

            } else {
                ln_rows_b(F, P_RB, nullptr, P_XB, P_MUST, KIN(16), KIN(17), TC, false);
            }
            SEAM(P + 0);
            }
        }
        if (IN(P + 1)) {
            PHASE_TID();
            { pg8::ProbLin g = pg8::make_lin((const pg8::bf16_t*)P_XB, DM, WL(W_IN), DM, DM); pg8::StaticOrder So; So.init(TC, NIN, F.G, (int)blockIdx.x);
              pg8::EpiInProj E{(pg8::bf16_t*)P_QKV, (pg8::bf16_t*)P_GATE, KIN(6) + (size_t)l * GATEW};
              pg8::gemm_phase(F.lds + RING_OFF, g, So, E); }
            { pg8::ProbF0 g; g.A = (const char*)WL(W_F); g.B = (const char*)P_XB; g.lgN2 = lgN2; g.K = DM; g.rsA = DM; g.rsB = (unsigned)DM << lgN2; g.hsA = 128L * DM * 2; g.hsB = DM * 2;
              pg8::StaticOrder So; So.init(1024, TC, F.G, (int)blockIdx.x);
              pg8::EpiF0 E{(pg8::bf16_t*)P_ZT, lgN2};
              pg8::gemm_phase(F.lds + RING_OFF, g, So, E); }
            SEAM(P + 1);
        }
        if (IN(P + 2)) {
            PHASE_TID();
            float lamfull;
            { const float* lm = KIN(7) + (size_t)l * 512; const float a = lm[F.lane] * lm[128 + F.lane] + lm[64 + F.lane] * lm[192 + F.lane];
              const float b2 = lm[256 + F.lane] * lm[384 + F.lane] + lm[320 + F.lane] * lm[448 + F.lane];
              const float laminit = l == 0 ? 0.2f : 0.35550906759096926f;
              lamfull = __uint_as_float(__builtin_amdgcn_readfirstlane(__float_as_uint(__expf(wave_sum(a, F.lane)) - __expf(wave_sum(b2, F.lane)) + laminit))); }
            const float oml = l == 0 ? 0.8f : 0.64449093240903074f;
            __syncthreads();
            const int nqb = S / 128;
            for (int ui = 0; ui < 4; ++ui) {
                const int uid = ui * F.G + F.vcu; if (uid >= Bc * 8 * nqb) break;
                const int bh = uid >> lgN2, qb = uid & (nqb - 1), b = bh >> 3, h = bh & 7;
                att3::attn_unit((const att3::bf16*)P_QKV + (size_t)b * S * QKVW, S, qb * 128, h, F.lds + RING_OFF, (float*)(lds + WSC_OFF), (const float*)(lds + TAB_OFF) + h * 260, lamfull);
                __syncthreads();
                PHASE_TID();
                {
                    const int row = F.tid >> 2, qd = F.tid & 3;
                    const LAS float* drow = (const LAS float*)(F.lds + RING_OFF) + row * 256; const int sw = (qd << 2) ^ ((row & 3) << 4);
                    f32x4 av[16]; float ssq = 0.f;
#pragma unroll
                    for (int j = 0; j < 16; ++j) { av[j] = *(const LAS f32x4*)(drow + ((qd * 64 + 4 * j) ^ sw)); ssq += (av[j].x * av[j].x + av[j].y * av[j].y) + (av[j].z * av[j].z + av[j].w * av[j].w); }
                    ssq += __uint_as_float((unsigned)__builtin_amdgcn_ds_bpermute((F.lane ^ 1) << 2, (int)__float_as_uint(ssq)));
                    ssq += __uint_as_float((unsigned)__builtin_amdgcn_ds_bpermute((F.lane ^ 2) << 2, (int)__float_as_uint(ssq)));
                    const float rs = oml / sqrtf(ssq * (1.0f / 256.0f) + LN_EPS);
                    int lq = l; asm volatile("" : "+s"(lq));
                    const f32x4* sg = (const f32x4*)(KIN(8) + lq * 256 + qd * 64);
                    bf16* orow = P_OB + ((size_t)b * S + qb * 128 + row) * DM + h * 256 + qd * 64;
#pragma unroll
                    for (int j = 0; j < 8; ++j) { const f32x4 a = av[2 * j], c2 = av[2 * j + 1], g0 = sg[2 * j], g1 = sg[2 * j + 1];
                        v4u w; w.x = pk2(a.x * rs * g0.x, a.y * rs * g0.y); w.y = pk2(a.z * rs * g0.z, a.w * rs * g0.w); w.z = pk2(c2.x * rs * g1.x, c2.y * rs * g1.y); w.w = pk2(c2.z * rs * g1.z, c2.w * rs * g1.w);
                        *(v4u*)(orow + 8 * j) = w; }
                }
                __syncthreads();
            }
            { pg8::ProbLin g = pg8::make_lin((const pg8::bf16_t*)P_DFT1, 256, (const pg8::bf16_t*)P_ZT, 256, 256); pg8::StaticOrder So; So.init(256, TC * 8, F.G, (int)blockIdx.x);
              pg8::EpiF1 E{(pg8::bf16_t*)P_G2, lgN2};
              pg8::gemm_phase(F.lds + RING_OFF, g, So, E); }
            SEAM(P + 2);
        }
        if (IN(P + 3)) {
            PHASE_TID();
            const pg8::bf16_t* M2 = P_M2(lgN2);
            pg8::ProbLin g = pg8::make_lin(M2, 512, (const pg8::bf16_t*)P_G2, 2 * S, 512); g.bPm = 512 * 2;
            pg8::StaticOrder So; So.init(S, Bc * 1024, F.G, (int)blockIdx.x);
            pg8::EpiF2 E{(pg8::bf16_t*)P_YB, lgN2};
            pg8::gemm_phase(F.lds + RING_OFF, g, So, E);
        }
        if (IN(P + 4)) {
            PHASE_TID();
            pg8::ProbLin g = pg8::make_lin((const pg8::bf16_t*)P_OB, DM, WL(W_A), DM, DM); pg8::StaticOrder So; So.init(TC, DM, F.G, (int)blockIdx.x);
            pg8::EpiGate<false> E{(pg8::bf16_t*)P_MERGED, (const pg8::bf16_t*)P_GATE, 0};
            pg8::gemm_phase(F.lds + RING_OFF, g, So, E);
            SEAM(P + 4);
        }
        if (IN(P + 5)) {
            PHASE_TID();
            pg8::ProbLin g = pg8::make_lin((const pg8::bf16_t*)P_YB, 1024, WL(W_F2), 1024, 1024); pg8::StaticOrder So; So.init(TC, DM, F.G, (int)blockIdx.x);
            pg8::EpiGate<true> E{(pg8::bf16_t*)P_MERGED, (const pg8::bf16_t*)P_GATE, 2048};
            pg8::gemm_phase(F.lds + RING_OFF, g, So, E);
            SEAM(P + 5);
        }
        if (IN(P + 6)) {
            PHASE_TID();
            pg8::ProbLin g = pg8::make_lin((const pg8::bf16_t*)P_MERGED, DM, WL(W_O), DM, DM); pg8::StaticOrder So; So.init(TC, DM, F.G, (int)blockIdx.x);
            if (l == 0) { const float* xin = c < 2 ? KIN(0) + (size_t)c * TC * DM : KIN(1) + (size_t)(c - 2) * TC * DM;
                pg8::EpiResB<true, true> E{xin, (pg8::bf16_t*)P_RB, ALPHA, P_MUST, KIN(3), KIN(4), P_STATP, (LAS float*)(F.lds + LRED_OFF)}; pg8::gemm_phase(F.lds + RING_OFF, g, So, E); }
            else { pg8::EpiResB<false, true> E{P_RB, (pg8::bf16_t*)P_RB, ALPHA, P_MUST, KIN(16), KIN(17), P_STATP, (LAS float*)(F.lds + LRED_OFF)}; pg8::gemm_phase(F.lds + RING_OFF, g, So, E); }
            SEAM(P + 6);
        }
        if (IN(P + 7)) {
            PHASE_TID();
        }
        if (IN(P + 8)) {
            PHASE_TID();
            pg8::ProbLin g = pg8::make_lin((const pg8::bf16_t*)P_RB, DM, WL(W_GU), DM, DM); pg8::StaticOrder So; So.init(TC, 2 * DFF, F.G, (int)blockIdx.x);
            {
                pg8::Unit uu; int lastpm = -1;
                for (int i = 0; So.next(i, uu); ++i) if (uu.pm != lastpm) { lastpm = uu.pm;
                    if (F.tid < 256) { const int row = uu.pm * 256 + F.tid; const f32x4* p = (const f32x4*)(P_STATP + (size_t)row * 16); const f32x4 a = p[0], b = p[1], c2_ = p[2], d = p[3];
                        const float S1 = ((a[0] + a[2]) + (b[0] + b[2])) + ((c2_[0] + c2_[2]) + (d[0] + d[2])), Q1 = ((a[1] + a[3]) + (b[1] + b[3])) + ((c2_[1] + c2_[3]) + (d[1] + d[3]));
                        const float mu = S1 * (1.f / DM); const float var = fmaxf(Q1 * (1.f / DM) - mu * mu, 0.f);
                        float2 o2; o2.x = mu; o2.y = 1.f / sqrtf(var + LN_EPS); *(float2*)(P_MUST + (size_t)row * 2) = o2; } }
                VM_WAIT(); __syncthreads();
            }
            pg8::EpiSwiGLU E{(pg8::bf16_t*)P_ACT, P_MUST, P_C12 + (size_t)l * 2 * INW, P_C12 + ((size_t)l * 2 + 1) * INW};
            pg8::gemm_phase(F.lds + RING_OFF, g, So, E);
            SEAM(P + 8);
        }
        if (IN(P + 9)) {
            PHASE_TID();
            pg8::ProbLin g = pg8::make_lin((const pg8::bf16_t*)P_ACT, DFF, WL(W_D), DFF, DFF); pg8::StaticOrder So; So.init(TC, DM, F.G, (int)blockIdx.x);
            pg8::EpiResB<false, false> E{P_RB, (pg8::bf16_t*)P_RB, ALPHA, P_MUST, KIN(12) + (size_t)l * DM, KIN(13) + (size_t)l * DM, nullptr, (LAS float*)(F.lds + LRED_OFF)};
            pg8::gemm_phase(F.lds + RING_OFF, g, So, E);
            SEAM(P + 9);
        }
    }
    if (IN(PH_TOTAL - 1)) {
        PHASE_TID();
        bool poison = false;
        if (!MK_PER_PHASE) poison = __hip_atomic_load((gu32*)(ctl + CW_BAR + XB_TMO), RLX_AGENT) != 0u;
        ln_rows_b(F, P_RB, KOUT + (size_t)(NCHUNK - 1) * TC * DM, nullptr, nullptr, KIN(16) + DM, KIN(17) + DM, TC, poison);
    }
#undef IN
#undef SEAM
}

extern "C" void kernel_launch(void* const* d_in, const int* in_sizes, int n_in, void* d_out, int out_size, void* d_ws, size_t ws_size, hipStream_t stream) {
    static int grid = 0;
    if (grid == 0) {
        if (n_in != 18 || in_sizes[0] != TOK / 2 * DM || out_size != TOK * DM || ws_size < WS_END) {
            fprintf(stderr, "kernel_launch: shape mismatch: n_in %d in0 %d out %d ws %zu (need %zu); nothing launched\n", n_in, n_in > 0 ? in_sizes[0] : -1, out_size, ws_size, (size_t)WS_END); grid = -1; return; }
        int dev = 0, cus = 0, per_cu = 0;
        if (hipGetDevice(&dev) != hipSuccess || hipDeviceGetAttribute(&cus, hipDeviceAttributeMultiprocessorCount, dev) != hipSuccess) { grid = -1; return; }
        if (hipFuncSetAttribute((const void*)fwd_kernel, hipFuncAttributeMaxDynamicSharedMemorySize, LDS_BYTES) != hipSuccess) { fprintf(stderr, "kernel_launch: hipFuncSetAttribute failed\n"); grid = -1; return; }
        if (hipOccupancyMaxActiveBlocksPerMultiprocessor(&per_cu, (const void*)fwd_kernel, NWAVES * 64, LDS_BYTES) != hipSuccess || per_cu < 1)
            fprintf(stderr, "kernel_launch: note: occupancy query reports %d workgroups per CU\n", per_cu);
        (void)hipGetLastError();
        grid = cus;
    }
    if (grid < 0) return;
    if (hipMemsetAsync((char*)d_ws + WS_CTL, 0, CTL_ZERO_BYTES, stream) != hipSuccess) { fprintf(stderr, "kernel_launch: memset failed\n"); return; }
    Args a{};
    for (int i = 0; i < 18; ++i) a.in[i] = (const float*)d_in[i];
    a.out = (float*)d_out; a.ws = (unsigned char*)d_ws;
    { unsigned char* w = (unsigned char*)d_ws; const size_t offs[17] = {WS_XB, WS_QKV, WS_GATE, WS_Z, WS_G2, WS_O, WS_DFT1, WS_M2P, WS_M2S, WS_W, WS_W + W_LAYER, WS_MUST, WS_RB, WS_C1P, WS_C2P, WS_C12, WS_STATP};
      for (int i = 0; i < 17; ++i) a.wsp[i] = w + offs[i]; }
#if MK_PER_PHASE
    for (int p = 0; p < PH_TOTAL; ++p) { a.ph_lo = p; a.ph_hi = p + 1; hipLaunchKernelGGL(fwd_kernel, dim3(grid), dim3(NWAVES * 64), LDS_BYTES, stream, a); }
#else
    a.ph_lo = 0; a.ph_hi = PH_TOTAL;
    hipLaunchKernelGGL(fwd_kernel, dim3(grid), dim3(NWAVES * 64), LDS_BYTES, stream, a);
#endif
    const hipError_t le = hipPeekAtLastError();
    if (le != hipSuccess) fprintf(stderr, "kernel_launch: launch failed: %s\n", hipGetErrorName(le));
}
```

```cpp
#include <hip/hip_runtime.h>
#include <hip/hip_bf16.h>
#include <cstdio>
#include <cstdint>

#ifndef MK_PER_PHASE
#define MK_PER_PHASE 0
#endif

namespace pg8 {
#define PG8_LAS __attribute__((address_space(3)))
typedef unsigned short bf16_t;
typedef short bf16x8 __attribute__((ext_vector_type(8)));
typedef float f32x4 __attribute__((ext_vector_type(4)));
typedef unsigned u32x4 __attribute__((ext_vector_type(4)));
constexpr int BM = 256, BK = 64, HALF = 128, HTB = HALF * BK * 2, STAGE_BYTES = 8 * HTB, NXCD = 8, WGM = 4;

__host__ __device__ __forceinline__ int lds_byte(int r, int c) { const int st = (r >> 4) * 2 + (c >> 5), rr = r & 15, cc = c & 31, ob = rr * 64 + cc * 2; return st * 1024 + (ob ^ (((ob >> 9) & 1) << 5)); }
__host__ __device__ __forceinline__ void stage_rc(int b, int& R, int& C) { const int st = b / 1024, sb = b % 1024, swz = sb ^ (((sb >> 9) & 1) << 5); R = (st >> 1) * 16 + swz / 64; C = (st & 1) * 32 + (swz % 64) / 2; }
__host__ __device__ __forceinline__ int perm32(int rho) { const int n = rho >> 4, i = rho & 15; return 8 * (i >> 2) + 4 * n + (i & 3); }

struct Unit { int pm, pn; };

struct StaticOrder {
    int nM, nN, nwg, G, c;
    __host__ __device__ void init(int M, int N, int G_, int c_) { nM = M / BM; nN = N / BM; nwg = nM * nN; G = G_; c = c_; }
    __host__ __device__ bool next(int i, Unit& u) const {
        const long L = (long)i * G + c; if (L >= nwg) return false;
        int wgid = (int)L; { const int q = nwg / NXCD, r = nwg % NXCD, xcd = wgid % NXCD, off = wgid / NXCD; wgid = (xcd < r ? xcd * (q + 1) : r * (q + 1) + (xcd - r) * q) + off; }
        const int nig = WGM * nN, gid = wgid / nig, fm = gid * WGM, gsz = (nM - fm) < WGM ? (nM - fm) : WGM;
        u.pm = fm + ((wgid % nig) % gsz); u.pn = (wgid % nig) / gsz; return true;
    }
};

struct ProbLin {
    const char* A; const char* B; long aUnit, bUnit, bPm; unsigned rsA, rsB; long hsA, hsB; int K;
    __device__ __forceinline__ const char* abase(const Unit& u) const { return A + (long)u.pm * aUnit; }
    __device__ __forceinline__ const char* bbase(const Unit& u) const { return B + (long)u.pn * bUnit + (long)u.pm * bPm; }
};
__device__ __forceinline__ ProbLin make_lin(const bf16_t* A, int lda, const bf16_t* B, int ldb, int K) {
    ProbLin p; p.A = (const char*)A; p.B = (const char*)B; p.aUnit = (long)BM * lda * 2; p.bUnit = (long)BM * ldb * 2; p.bPm = 0; p.rsA = (unsigned)lda; p.rsB = (unsigned)ldb;
    p.hsA = (long)HALF * lda * 2; p.hsB = (long)HALF * ldb * 2; p.K = K; return p;
}
struct ProbF0 {
    const char* A; const char* B; int lgN2; int K;
    unsigned rsA, rsB; long hsA, hsB;
    __device__ __forceinline__ const char* abase(const Unit& u) const { return A + (long)u.pm * (256L * 2048 * 2); }
    __device__ __forceinline__ const char* bbase(const Unit& u) const { const int bs = 2 * u.pn, b = bs >> lgN2, s2 = bs & ((1 << lgN2) - 1); return B + ((long)b * (128L << lgN2) + s2) * 4096L; }
};

typedef float f32x2_t_ __attribute__((ext_vector_type(2))); typedef __bf16 bf16x2_t_ __attribute__((ext_vector_type(2)));
__device__ __forceinline__ unsigned cvt_pk_bf16(float lo, float hi) { const f32x2_t_ v = {lo, hi}; return __builtin_bit_cast(unsigned, __builtin_convertvector(v, bf16x2_t_)); }
__device__ __forceinline__ float bf_lo(unsigned w) { return __uint_as_float(w << 16); }
__device__ __forceinline__ float bf_hi(unsigned w) { return __uint_as_float(w & 0xffff0000u); }
__device__ __forceinline__ float sigmoidf_(float x) { return __builtin_amdgcn_rcpf(1.0f + __expf(-x)); }

#define PG8_PACK8(v0, v1) ((u32x4){cvt_pk_bf16((v0)[0], (v0)[1]), cvt_pk_bf16((v0)[2], (v0)[3]), cvt_pk_bf16((v1)[0], (v1)[1]), cvt_pk_bf16((v1)[2], (v1)[3])})

struct EpiInProj {
    static constexpr bool PERM = true;
    bf16_t* qkv; bf16_t* gate; const float* bgate;
    __device__ __forceinline__ void operator()(const f32x4 (&acc)[2][2][4][2], const Unit& u, int wr, int wc, int fr, int fq) const {
        const int row0 = u.pm * BM + wr * 64 + fr; const bool isg = u.pn >= 24;
        const int colt = isg ? (u.pn - 24) * BM : u.pn * BM; bf16_t* base = isg ? gate : qkv; const int ldc = isg ? 4096 : 6144;
        const int col0 = colt + wc * 32 + 8 * fq;
        f32x4 bv[2][2];
#pragma unroll
        for (int bj = 0; bj < 2; ++bj)
#pragma unroll
            for (int n = 0; n < 2; ++n) bv[bj][n] = isg ? *(const f32x4*)(bgate + col0 + bj * HALF + 4 * n) : (f32x4){0.f, 0.f, 0.f, 0.f};
#pragma unroll
        for (int ai = 0; ai < 2; ++ai)
#pragma unroll
            for (int m = 0; m < 4; ++m) { bf16_t* rowp = base + (size_t)(row0 + ai * HALF + m * 16) * ldc + col0;
#pragma unroll
                for (int bj = 0; bj < 2; ++bj) { f32x4 v0 = acc[ai][bj][m][0] + bv[bj][0], v1 = acc[ai][bj][m][1] + bv[bj][1];
                    if (isg) {
#pragma unroll
                        for (int e = 0; e < 4; ++e) { v0[e] = sigmoidf_(v0[e]); v1[e] = sigmoidf_(v1[e]); } }
                    *(u32x4*)(rowp + bj * HALF) = PG8_PACK8(v0, v1); } }
    }
};
struct EpiF0 {
    static constexpr bool PERM = true;
    bf16_t* Zt; int lgN2;
    __device__ __forceinline__ void operator()(const f32x4 (&acc)[2][2][4][2], const Unit& u, int wr, int wc, int fr, int fq) const {
#pragma unroll
        for (int bj = 0; bj < 2; ++bj) { const int bs = 2 * u.pn + bj, b = bs >> lgN2, s2 = bs & ((1 << lgN2) - 1);
#pragma unroll
            for (int ai = 0; ai < 2; ++ai)
#pragma unroll
                for (int m = 0; m < 4; ++m) { const int r = u.pm * BM + ai * HALF + wr * 64 + m * 16 + fr;
                    int part, g, c;
                    if (r < 520) { part = 0; g = r / 65; c = r - g * 65; } else { const int q = r - 520; part = 1; g = q / 63; c = q - g * 63 + 1; }
                    const u32x4 v = PG8_PACK8(acc[ai][bj][m][0], acc[ai][bj][m][1]);
                    const size_t a0 = (((((size_t)(b * 1024 + g * 128 + c)) << lgN2) + s2) * 2 + part) * 128 + wc * 32 + 8 * fq;
                    *(u32x4*)(Zt + a0) = v;
                    if (c != 0 && c != 64) { const size_t a1 = (((((size_t)(b * 1024 + g * 128 + 128 - c)) << lgN2) + s2) * 2 + part) * 128 + wc * 32 + 8 * fq;
                        const unsigned sg = part ? 0x80008000u : 0u; *(u32x4*)(Zt + a1) = (u32x4){v[0] ^ sg, v[1] ^ sg, v[2] ^ sg, v[3] ^ sg}; }
                    else *(u32x4*)(Zt + a0 + 128) = (u32x4){0u, 0u, 0u, 0u}; } }
    }
};
struct EpiF1 {
    static constexpr bool PERM = true;
    bf16_t* G2; int lgN2;
    __device__ __forceinline__ void operator()(const f32x4 (&acc)[2][2][4][2], const Unit& u, int wr, int wc, int fr, int fq) const {
#pragma unroll
        for (int bj = 0; bj < 2; ++bj) { const int n = u.pn * BM + bj * HALF + wc * 32 + 8 * fq, bc = n >> lgN2, s2 = n & ((1 << lgN2) - 1);
#pragma unroll
            for (int ai = 0; ai < 2; ++ai)
#pragma unroll
                for (int m = 0; m < 4; ++m) { const int k1 = wr * 64 + m * 16 + fr;
                    const size_t addr = ((((size_t)bc * 128 + k1) * 2 + ai) << lgN2) + s2;
                    *(u32x4*)(G2 + addr) = PG8_PACK8(acc[ai][bj][m][0], acc[ai][bj][m][1]); } }
    }
};
struct EpiF2 {
    static constexpr bool PERM = true;
    bf16_t* Y; int lgN2;
    __device__ __forceinline__ void operator()(const f32x4 (&acc)[2][2][4][2], const Unit& u, int wr, int wc, int fr, int fq) const {
        const int gk = 256 >> lgN2;
#pragma unroll
        for (int ai = 0; ai < 2; ++ai)
#pragma unroll
            for (int m = 0; m < 4; ++m) { const int mm = ai * HALF + wr * 64 + m * 16 + fr, k1l = mm >> lgN2, k2 = mm & ((1 << lgN2) - 1), tok = u.pm * gk + k1l + 128 * k2;
#pragma unroll
                for (int bj = 0; bj < 2; ++bj) { const int n = u.pn * BM + bj * HALF + wc * 32 + 8 * fq, b = n >> 10, ch = n & 1023;
                    const size_t addr = ((size_t)b * (128 << lgN2) + tok) * 1024 + ch;
                    *(u32x4*)(Y + addr) = PG8_PACK8(acc[ai][bj][m][0], acc[ai][bj][m][1]); } }
    }
};
template <bool SECOND> struct EpiGate {
    static constexpr bool PERM = true;
    bf16_t* merged; const bf16_t* gate; int goff;
    __device__ __forceinline__ void operator()(const f32x4 (&acc)[2][2][4][2], const Unit& u, int wr, int wc, int fr, int fq) const {
        const int row0 = u.pm * BM + wr * 64 + fr, col0 = u.pn * BM + wc * 32 + 8 * fq;
        constexpr int MB = SECOND ? 2 : 4;
#pragma unroll
        for (int ai = 0; ai < 2; ++ai)
#pragma unroll
          for (int mb = 0; mb < 4; mb += MB) { u32x4 gq[MB][2], oq[MB][2];
#pragma unroll
            for (int m = 0; m < MB; ++m)
#pragma unroll
                for (int bj = 0; bj < 2; ++bj) { const size_t row = (size_t)(row0 + ai * HALF + (mb + m) * 16); const int col = col0 + bj * HALF;
                    gq[m][bj] = *(const u32x4*)(gate + row * 4096 + goff + col); if (SECOND) oq[m][bj] = *(const u32x4*)(merged + row * 2048 + col); }
            asm volatile("" ::: "memory");
#pragma unroll
            for (int m = 0; m < MB; ++m)
#pragma unroll
                for (int bj = 0; bj < 2; ++bj) { const size_t row = (size_t)(row0 + ai * HALF + (mb + m) * 16); const int col = col0 + bj * HALF; const u32x4 g = gq[m][bj];
                    f32x4 v0 = acc[ai][bj][mb + m][0], v1 = acc[ai][bj][mb + m][1];
                    v0[0] *= bf_lo(g.x); v0[1] *= bf_hi(g.x); v0[2] *= bf_lo(g.y); v0[3] *= bf_hi(g.y);
                    v1[0] *= bf_lo(g.z); v1[1] *= bf_hi(g.z); v1[2] *= bf_lo(g.w); v1[3] *= bf_hi(g.w);
                    if (SECOND) { const u32x4 o = oq[m][bj];
                        v0[0] += bf_lo(o.x); v0[1] += bf_hi(o.x); v0[2] += bf_lo(o.y); v0[3] += bf_hi(o.y);
                        v1[0] += bf_lo(o.z); v1[1] += bf_hi(o.z); v1[2] += bf_lo(o.w); v1[3] += bf_hi(o.w); }
                    *(u32x4*)(merged + row * 2048 + col) = PG8_PACK8(v0, v1); }
            asm volatile("" ::: "memory"); }
    }
};
__device__ __forceinline__ float xsum16(float v) { auto r = __builtin_amdgcn_permlane16_swap(__float_as_uint(v), __float_as_uint(v), false, false); return __uint_as_float(r[0]) + __uint_as_float(r[1]); }
__device__ __forceinline__ float xsum32(float v) { auto r = __builtin_amdgcn_permlane32_swap(__float_as_uint(v), __float_as_uint(v), false, false); return __uint_as_float(r[0]) + __uint_as_float(r[1]); }
template <bool SRCF32, bool EMIT> struct EpiResB {
    static constexpr bool PERM = true;
    const void* src; bf16_t* dst; float alpha; const float* must; const float* gam; const float* bet; float* statp; PG8_LAS float* lred;
    __device__ __forceinline__ void operator()(const f32x4 (&acc)[2][2][4][2], const Unit& u, int wr, int wc, int fr, int fq) const {
        const int row0 = u.pm * BM + wr * 64 + fr, col0 = u.pn * BM + wc * 32 + 8 * fq;
        f32x4 gv[2][2], bv[2][2];
#pragma unroll
        for (int bj = 0; bj < 2; ++bj)
#pragma unroll
            for (int n = 0; n < 2; ++n) { gv[bj][n] = *(const f32x4*)(gam + col0 + bj * HALF + 4 * n); bv[bj][n] = *(const f32x4*)(bet + col0 + bj * HALF + 4 * n); }
        constexpr int MB = (SRCF32 ? 2 : 4) / (EMIT ? 2 : 1);
#pragma unroll
        for (int ai = 0; ai < 2; ++ai)
#pragma unroll
          for (int mb = 0; mb < 4; mb += MB) { float2 ms[MB]; u32x4 xb[MB][2]; f32x4 xf[MB][2][2];
#pragma unroll
            for (int m = 0; m < MB; ++m) { const size_t ro = (size_t)(row0 + ai * HALF + (mb + m) * 16); ms[m] = *(const float2*)(must + ro * 2);
#pragma unroll
                for (int bj = 0; bj < 2; ++bj) { const size_t o = ro * 2048 + col0 + bj * HALF;
                    if (SRCF32) { xf[m][bj][0] = *(const f32x4*)((const float*)src + o); xf[m][bj][1] = *(const f32x4*)((const float*)src + o + 4); }
                    else xb[m][bj] = *(const u32x4*)((const bf16_t*)src + o); } }
            asm volatile("" ::: "memory");
#pragma unroll
            for (int m = 0; m < MB; ++m) { const size_t ro = (size_t)(row0 + ai * HALF + (mb + m) * 16); float s = 0.f, q = 0.f;
#pragma unroll
                for (int bj = 0; bj < 2; ++bj) { const size_t o = ro * 2048 + col0 + bj * HALF; f32x4 x0, x1;
                    if (SRCF32) { x0 = xf[m][bj][0]; x1 = xf[m][bj][1]; }
                    else { const u32x4 w = xb[m][bj]; x0 = (f32x4){bf_lo(w.x), bf_hi(w.x), bf_lo(w.y), bf_hi(w.y)}; x1 = (f32x4){bf_lo(w.z), bf_hi(w.z), bf_lo(w.w), bf_hi(w.w)}; }
                    x0 = (x0 - ms[m].x) * ms[m].y * gv[bj][0] + bv[bj][0]; x1 = (x1 - ms[m].x) * ms[m].y * gv[bj][1] + bv[bj][1];
                    const f32x4 v0 = x0 * alpha + acc[ai][bj][mb + m][0], v1 = x1 * alpha + acc[ai][bj][mb + m][1];
                    if (EMIT) { s += ((v0[0] + v0[1]) + (v0[2] + v0[3])) + ((v1[0] + v1[1]) + (v1[2] + v1[3]));
                        q += ((v0[0] * v0[0] + v0[1] * v0[1]) + (v0[2] * v0[2] + v0[3] * v0[3])) + ((v1[0] * v1[0] + v1[1] * v1[1]) + (v1[2] * v1[2] + v1[3] * v1[3])); }
                    *(u32x4*)(dst + o) = PG8_PACK8(v0, v1); }
                if (EMIT) { s = xsum16(s); s = xsum32(s); q = xsum16(q); q = xsum32(q);
                    if (fq == 0) { PG8_LAS float* d = lred + ((ai * HALF + wr * 64 + (mb + m) * 16 + fr) * 4 + wc) * 2; d[0] = s; d[1] = q; } } }
            asm volatile("" ::: "memory"); }
        if (EMIT) {
            asm volatile("s_waitcnt lgkmcnt(0)" ::: "memory"); __builtin_amdgcn_s_barrier(); asm volatile("" ::: "memory");
            const int t = (wr * 4 + wc) * 64 + fq * 16 + fr;
            if (t < 256) { const PG8_LAS f32x4* d = (const PG8_LAS f32x4*)(lred + t * 8); const f32x4 a = d[0], b = d[1];
                float2 o2; o2.x = (a[0] + a[2]) + (b[0] + b[2]); o2.y = (a[1] + a[3]) + (b[1] + b[3]);
                *(float2*)(statp + ((size_t)(u.pm * BM + t) * 8 + u.pn) * 2) = o2; }
        }
    }
};
struct EpiSwiGLU {
    static constexpr bool PERM = true;
    bf16_t* act; const float* must; const float* c1; const float* c2;
    __device__ __forceinline__ void operator()(const f32x4 (&acc)[2][2][4][2], const Unit& u, int wr, int wc, int fr, int fq) const {
        const int row0 = u.pm * BM + wr * 64 + fr, col0 = u.pn * HALF + wc * 32 + 8 * fq, n0 = u.pn * BM + wc * 32 + 8 * fq;
        f32x4 k1[2][2], k2[2][2]; float2 ms[2][4];
#pragma unroll
        for (int bj = 0; bj < 2; ++bj)
#pragma unroll
            for (int n = 0; n < 2; ++n) { k1[bj][n] = *(const f32x4*)(c1 + n0 + bj * HALF + 4 * n); k2[bj][n] = *(const f32x4*)(c2 + n0 + bj * HALF + 4 * n); }
#pragma unroll
        for (int ai = 0; ai < 2; ++ai)
#pragma unroll
            for (int m = 0; m < 4; ++m) ms[ai][m] = *(const float2*)(must + (size_t)(row0 + ai * HALF + m * 16) * 2);
#pragma unroll
        for (int ai = 0; ai < 2; ++ai)
#pragma unroll
            for (int m = 0; m < 4; ++m) { const int row = row0 + ai * HALF + m * 16; const float mu = ms[ai][m].x, rs = ms[ai][m].y; f32x4 v0, v1;
#pragma unroll
                for (int e = 0; e < 4; ++e) {
                    const float g0 = rs * (acc[ai][0][m][0][e] - mu * k1[0][0][e]) + k2[0][0][e], g1 = rs * (acc[ai][0][m][1][e] - mu * k1[0][1][e]) + k2[0][1][e];
                    const float u0 = rs * (acc[ai][1][m][0][e] - mu * k1[1][0][e]) + k2[1][0][e], u1 = rs * (acc[ai][1][m][1][e] - mu * k1[1][1][e]) + k2[1][1][e];
                    v0[e] = g0 * sigmoidf_(g0) * u0; v1[e] = g1 * sigmoidf_(g1) * u1; }
                *(u32x4*)(act + (size_t)row * 5632 + col0) = PG8_PACK8(v0, v1); }
    }
};

template <class Prob, class Epi, class Sched>
__device__ __forceinline__ void gemm_phase(PG8_LAS unsigned char* lds, const Prob g, const Sched& S, const Epi& E) {
    int tid_ = threadIdx.x; asm volatile("" : "+v"(tid_));
    const int tid = tid_, wid = __builtin_amdgcn_readfirstlane(tid >> 6), lane = tid & 63, wr = wid >> 2, wc = wid & 3, fr = lane & 15, fq = lane >> 4;
    const int nt = g.K / BK;
    unsigned voffA[2], voffB[2];
#pragma unroll
    for (int i = 0; i < 2; ++i) { int R, C; stage_rc(tid * 16 + i * 8192, R, C); const int Rb = Epi::PERM ? ((R & ~31) + perm32(R & 31)) : R;
        voffA[i] = ((unsigned)R * g.rsA + (unsigned)C) * 2u; voffB[i] = ((unsigned)Rb * g.rsB + (unsigned)C) * 2u; }
    const size_t kstep = (size_t)(BK * 2);
    const long hstepA = g.hsA, hstepB = g.hsB;
    const unsigned ldsw = (unsigned)wid * 1024u;
    const int aoff = lds_byte(wr * 64 + fr, fq * 8), boff = lds_byte(wc * 32 + fr, fq * 8);
#define PG8_SA(b, h) (((b) * 2 + (h)) * HTB)
#define PG8_SB(b, h) ((4 + (b) * 2 + (h)) * HTB)
#define PG8_STAGE(bufoff, gbase, voff) do { _Pragma("unroll") for (int _i = 0; _i < 2; ++_i) \
        __builtin_amdgcn_global_load_lds((const unsigned*)((const char*)(gbase) + (voff)[_i]), (PG8_LAS unsigned*)(lds + (bufoff) + ldsw + _i * 8192), 16, 0, 0); } while (0)
#define PG8_LDA(dst, b, h) do { _Pragma("unroll") for (int m = 0; m < 4; ++m) _Pragma("unroll") for (int k = 0; k < 2; ++k) dst[m][k] = *(const PG8_LAS bf16x8*)(lds + PG8_SA(b, h) + aoff + m * 2048 + k * 1024); } while (0)
#define PG8_LDB(dst, b, h) do { _Pragma("unroll") for (int n = 0; n < 2; ++n) _Pragma("unroll") for (int k = 0; k < 2; ++k) dst[n][k] = *(const PG8_LAS bf16x8*)(lds + PG8_SB(b, h) + boff + n * 2048 + k * 1024); } while (0)
#define PG8_MMA(ai, bj, At, Bt) do { __builtin_amdgcn_s_setprio(1); _Pragma("unroll") for (int m = 0; m < 4; ++m) _Pragma("unroll") for (int n = 0; n < 2; ++n) _Pragma("unroll") for (int k = 0; k < 2; ++k) \
        acc[ai][bj][m][n] = __builtin_amdgcn_mfma_f32_16x16x32_bf16(Bt[n][k], At[m][k], acc[ai][bj][m][n], 0, 0, 0); __builtin_amdgcn_s_setprio(0); } while (0)
#define PG8_WAIT_V(n) asm volatile("s_waitcnt vmcnt(" #n ")" ::: "memory")
#define PG8_WAIT_L(n) asm volatile("s_waitcnt lgkmcnt(" #n ")" ::: "memory")
#define PG8_BAR __builtin_amdgcn_s_barrier()
#define PG8_SCHED __builtin_amdgcn_sched_barrier(0)
    Unit cur, nxt; int ui = 0;
    if (!S.next(0, cur)) return;
    f32x4 acc[2][2][4][2];
#pragma unroll
    for (int a = 0; a < 2; ++a)
#pragma unroll
        for (int b = 0; b < 2; ++b)
#pragma unroll
            for (int m = 0; m < 4; ++m)
#pragma unroll
                for (int n = 0; n < 2; ++n) acc[a][b][m][n] = (f32x4){0.f, 0.f, 0.f, 0.f};
    bf16x8 At[4][2], B0[2][2], B1[2][2];
    const char* cA = g.abase(cur); const char* cB = g.bbase(cur);
    PG8_STAGE(PG8_SB(0, 0), cB, voffB); PG8_STAGE(PG8_SB(0, 1), cB + hstepB, voffB); PG8_STAGE(PG8_SA(0, 0), cA, voffA); PG8_STAGE(PG8_SA(0, 1), cA + hstepA, voffA);
    if (wr == 1) PG8_BAR;
    PG8_WAIT_V(2); PG8_BAR;
    PG8_STAGE(PG8_SB(1, 0), cB + kstep, voffB); PG8_STAGE(PG8_SA(1, 0), cA + kstep, voffA); PG8_STAGE(PG8_SB(1, 1), cB + hstepB + kstep, voffB);
    PG8_WAIT_V(6); PG8_BAR;
    for (;;) {
        const bool has_next = S.next(ui + 1, nxt);
        const char* nA = has_next ? g.abase(nxt) : cA; const char* nB = has_next ? g.bbase(nxt) : cB;
        for (int t = 0; t < nt; t += 2) {
            const bool last = (t == nt - 2);
            const char* a1 = cA + (size_t)(t + 1) * kstep;
            const char* a2 = last ? nA : cA + (size_t)(t + 2) * kstep; const char* b2 = last ? nB : cB + (size_t)(t + 2) * kstep;
            const char* a3 = a2 + kstep; const char* b3 = b2 + kstep;
            PG8_LDB(B0, 0, 0); PG8_LDB(B1, 0, 1); PG8_SCHED; PG8_LDA(At, 0, 0); PG8_STAGE(PG8_SA(1, 1), a1 + hstepA, voffA);
            PG8_WAIT_V(8); PG8_WAIT_L(0); PG8_BAR; PG8_MMA(0, 0, At, B0); PG8_MMA(0, 1, At, B1); PG8_BAR; PG8_SCHED;
            PG8_LDA(At, 0, 1); PG8_STAGE(PG8_SB(0, 0), b2, voffB); PG8_STAGE(PG8_SB(0, 1), b2 + hstepB, voffB); PG8_STAGE(PG8_SA(0, 0), a2, voffA);
            PG8_WAIT_V(8); PG8_WAIT_L(0); PG8_BAR; PG8_MMA(1, 0, At, B0); PG8_MMA(1, 1, At, B1); PG8_BAR; PG8_SCHED;
            PG8_LDB(B0, 1, 0); PG8_LDB(B1, 1, 1); PG8_SCHED; PG8_LDA(At, 1, 0); PG8_STAGE(PG8_SA(0, 1), a2 + hstepA, voffA);
            PG8_WAIT_V(8); PG8_WAIT_L(0); PG8_BAR; PG8_MMA(0, 0, At, B0); PG8_MMA(0, 1, At, B1); PG8_BAR; PG8_SCHED;
            PG8_LDA(At, 1, 1); PG8_STAGE(PG8_SB(1, 0), b3, voffB); PG8_STAGE(PG8_SB(1, 1), b3 + hstepB, voffB); PG8_STAGE(PG8_SA(1, 0), a3, voffA);
            PG8_WAIT_V(8); PG8_WAIT_L(0); PG8_BAR; PG8_MMA(1, 0, At, B0); PG8_MMA(1, 1, At, B1); PG8_BAR; PG8_SCHED;
        }
        if (wr == 0) PG8_BAR;
        E(acc, cur, wr, wc, fr, fq);
        if (!has_next) break;
#pragma unroll
        for (int a = 0; a < 2; ++a)
#pragma unroll
            for (int b = 0; b < 2; ++b)
#pragma unroll
                for (int m = 0; m < 4; ++m)
#pragma unroll
                    for (int n = 0; n < 2; ++n) acc[a][b][m][n] = (f32x4){0.f, 0.f, 0.f, 0.f};
        cur = nxt; cA = nA; cB = nB; ++ui;
        if (wr == 1) PG8_BAR;
    }
    PG8_WAIT_V(0);
    PG8_BAR;
#undef PG8_SA
#undef PG8_SB
#undef PG8_STAGE
#undef PG8_LDA
#undef PG8_LDB
#undef PG8_MMA
#undef PG8_WAIT_V
#undef PG8_WAIT_L
#undef PG8_BAR
#undef PG8_SCHED
}
}

namespace att3 {
using bf16 = __hip_bfloat16;
using bf16x8 = __attribute__((ext_vector_type(8))) short;
using s16x4  = __attribute__((ext_vector_type(4))) short;
using f32x16 = __attribute__((ext_vector_type(16))) float;
using u32x4  = __attribute__((ext_vector_type(4))) unsigned;
typedef __attribute__((address_space(3))) unsigned char* ldsp_t;
typedef __attribute__((address_space(3))) const char* ldsc_t;
typedef short v4i16_t __attribute__((ext_vector_type(4)));
constexpr int   LD = 6144;
constexpr float SCALE = 0.088388347648318440f;
constexpr float THR = 8.f;
constexpr int STAGE = 65536, V_OFF = 32768;
#define SBAR() __builtin_amdgcn_sched_barrier(0)
__device__ __forceinline__ int crow(int r, int hi) { return (r & 3) + 8 * (r >> 2) + 4 * hi; }
__device__ __forceinline__ unsigned cvtpk(float lo, float hi) { unsigned r; asm volatile("v_cvt_pk_bf16_f32 %0, %1, %2" : "=v"(r) : "v"(lo), "v"(hi)); return r; }
__device__ __forceinline__ s16x4 vtr(ldsc_t p) { return __builtin_bit_cast(s16x4, __builtin_amdgcn_ds_read_tr16_b64_v4i16((__attribute__((address_space(3))) v4i16_t*)p)); }

template <class Hook> __device__ __forceinline__ void qk_sub(f32x16& p, ldsc_t k0, ldsc_t k1, ldsc_t k2, ldsc_t k3, int kd, const bf16x8* qr, const Hook& hook) {
#define KF(a, o) (*(const __attribute__((address_space(3))) bf16x8*)((a) + (o)))
  SBAR();
  bf16x8 f0 = KF(k0, 0), f1 = KF(k1, 0), f2 = KF(k2, 0), f3 = KF(k3, 0); SBAR();
  p = __builtin_amdgcn_mfma_f32_32x32x16_bf16(f0, qr[0], f32x16{}, 0, 0, 0); f0 = KF(k0 + kd, 0); SBAR();
  p = __builtin_amdgcn_mfma_f32_32x32x16_bf16(f1, qr[1], p, 0, 0, 0); f1 = KF(k1 + kd, 0); hook(0); SBAR();
  p = __builtin_amdgcn_mfma_f32_32x32x16_bf16(f2, qr[2], p, 0, 0, 0); f2 = KF(k2 + kd, 0); SBAR();
  p = __builtin_amdgcn_mfma_f32_32x32x16_bf16(f3, qr[3], p, 0, 0, 0); f3 = KF(k3 + kd, 0); hook(1); SBAR();
  p = __builtin_amdgcn_mfma_f32_32x32x16_bf16(f0, qr[4], p, 0, 0, 0); SBAR();
  p = __builtin_amdgcn_mfma_f32_32x32x16_bf16(f1, qr[5], p, 0, 0, 0); hook(2); SBAR();
  p = __builtin_amdgcn_mfma_f32_32x32x16_bf16(f2, qr[6], p, 0, 0, 0); SBAR();
  p = __builtin_amdgcn_mfma_f32_32x32x16_bf16(f3, qr[7], p, 0, 0, 0); hook(3); SBAR();
#undef KF
}
__device__ __forceinline__ int v_rd_base(int lane) { return ((lane & 3) << 3) | (((lane >> 2) & 3) << 6) | (((lane >> 4) & 1) << 5) | (((lane >> 5) & 1) << 8); }
constexpr int v_rd_off(int d0, int ks, int half) { return d0 * 512 + ks * 8192 + half * 4096; }
struct VG { s16x4 l0, h0, l1, h1; };
template <int D0, int S> __device__ __forceinline__ VG vload(ldsc_t vb) { VG g; g.l0 = vtr(vb + v_rd_off(D0, 2 * S, 0)); g.h0 = vtr(vb + v_rd_off(D0, 2 * S, 1)); g.l1 = vtr(vb + v_rd_off(D0, 2 * S + 1, 0)); g.h1 = vtr(vb + v_rd_off(D0, 2 * S + 1, 1)); return g; }
#define PK(L, H) (bf16x8){L[0], L[1], L[2], L[3], H[0], H[1], H[2], H[3]}
__device__ __forceinline__ void vmma(f32x16& od, const VG& g, bf16x8 pa0, bf16x8 pa1) {
  od = __builtin_amdgcn_mfma_f32_32x32x16_bf16(pa0, PK(g.l0, g.h0), od, 0, 0, 0);
  od = __builtin_amdgcn_mfma_f32_32x32x16_bf16(pa1, PK(g.l1, g.h1), od, 0, 0, 0);
}
#undef PK
__device__ __forceinline__ void softmax_sub(f32x16& p, float& m_reg, float& l_reg, bf16x8& pa0, bf16x8& pa1, f32x16 (&o)[8], float* al_l, int r32, int hi, int dj, const float* tab, float cL, float cR) {
  constexpr float C = SCALE * 1.4426950408889634f;
  float cb;
  if (dj <= -159) cb = cL;
  else if (dj >= 159) cb = cR;
  else { cb = 0.f; const int ib = dj - r32 + 4 * hi + 128;
#pragma unroll
    for (int r = 0; r < 16; ++r) { const int i0 = ib + (r & 3) + 8 * (r >> 2); p[r] += tab[min(max(i0, 0), 256)]; } }
  float pmax = p[0];
#pragma unroll
  for (int r = 1; r < 16; ++r) pmax = fmaxf(pmax, p[r]);
  { auto rr = __builtin_amdgcn_permlane32_swap(__float_as_uint(pmax), __float_as_uint(pmax), false, false);
    pmax = fmaxf(__uint_as_float(rr[0]), __uint_as_float(rr[1])) + cb; }
  float mn, alpha;
  if (__builtin_expect(__all(pmax - m_reg <= THR / SCALE), 1)) { mn = m_reg; alpha = 1.f; }
  else { mn = fmaxf(m_reg, pmax); alpha = __builtin_amdgcn_exp2f((m_reg - mn) * C); m_reg = mn;
    if (hi == 0) al_l[r32] = alpha; asm volatile("s_waitcnt lgkmcnt(0)" ::: "memory");
#pragma unroll
    for (int d = 0; d < 8; ++d)
#pragma unroll
      for (int r = 0; r < 16; ++r) o[d][r] *= al_l[crow(r, hi)]; }
  const float mnC = (cb - mn) * C;
  float ps = 0;
#pragma unroll
  for (int r = 0; r < 16; ++r) { p[r] = __builtin_amdgcn_exp2f(fmaf(p[r], C, mnC)); ps += p[r]; }
  { auto rr = __builtin_amdgcn_permlane32_swap(__float_as_uint(ps), __float_as_uint(ps), false, false);
    ps = __uint_as_float(rr[0]) + __uint_as_float(rr[1]); }
  l_reg = l_reg * alpha + ps;
#define PK4(P, BASE, OUT) do { unsigned a0 = cvtpk(P[BASE + 0], P[BASE + 1]), a1 = cvtpk(P[BASE + 2], P[BASE + 3]);   \
    unsigned b0 = cvtpk(P[BASE + 4], P[BASE + 5]), b1 = cvtpk(P[BASE + 6], P[BASE + 7]);                              \
    auto r0 = __builtin_amdgcn_permlane32_swap(a0, b0, false, false); auto r1 = __builtin_amdgcn_permlane32_swap(a1, b1, false, false); \
    u32x4 w = {r0[0], r1[0], r0[1], r1[1]}; OUT = *reinterpret_cast<bf16x8*>(&w); } while (0)
  PK4(p, 0, pa0); PK4(p, 8, pa1);
#undef PK4
}
template <int S, class Dma> __device__ __forceinline__ void pv_run(f32x16 (&o)[8], ldsc_t vb, VG g0, VG g1, bf16x8 pa0, bf16x8 pa1, const Dma& dma) {
  SBAR(); __builtin_amdgcn_s_setprio(1);
  vmma(o[0], g0, pa0, pa1); dma(0); SBAR(); g0 = vload<2, S>(vb); SBAR();
  vmma(o[1], g1, pa0, pa1); dma(1); SBAR(); g1 = vload<3, S>(vb); SBAR();
  vmma(o[2], g0, pa0, pa1); dma(2); SBAR(); g0 = vload<4, S>(vb); SBAR();
  vmma(o[3], g1, pa0, pa1); dma(3); SBAR(); g1 = vload<5, S>(vb); SBAR();
  vmma(o[4], g0, pa0, pa1); dma(4); SBAR(); g0 = vload<6, S>(vb); SBAR();
  vmma(o[5], g1, pa0, pa1); dma(5); SBAR(); g1 = vload<7, S>(vb); SBAR();
  vmma(o[6], g0, pa0, pa1); dma(6); SBAR(); vmma(o[7], g1, pa0, pa1); dma(7); __builtin_amdgcn_s_setprio(0); SBAR();
}

__device__ __forceinline__ void attn_unit(const bf16* __restrict__ qkvb, int seq, int q0, int h, ldsp_t ldsb, float* wsc, const float* tab, float lam) {
  int tid_ = threadIdx.x; asm volatile("" : "+v"(tid_));
  const int tid = tid_, wid = __builtin_amdgcn_readfirstlane(tid >> 6), lane = tid & 63, r32 = lane & 31, hi = lane >> 5, mapw = wid >> 2, rg = wid & 3;
  float* ws = wsc + wid * 64; float* li_l = ws; float* al_l = ws + 32;
  float m_reg = -1e30f, l_reg = 0; bf16x8 qr[8]; f32x16 o[8];
#pragma unroll
  for (int d = 0; d < 8; ++d) o[d] = f32x16{};
  const int q0w = q0 + rg * 32;
  const bf16* Qw = qkvb + (long)(q0w + r32) * LD + h * 256 + mapw * 128 + hi * 8;
#pragma unroll
  for (int d0 = 0; d0 < 8; ++d0) qr[d0] = *reinterpret_cast<const bf16x8*>(Qw + d0 * 16);
  unsigned koff0, voff0;
  { const int row = 4 * wid + (lane >> 4), c = (lane & 15) ^ (row & 15); koff0 = (unsigned)(row * LD + 2048 + h * 256 + c * 8) * 2u; }
  { const int subt = 2 * wid + (lane >> 5), kk = ((subt >> 3) << 3) | ((lane & 31) >> 2), key = (kk & ~0xC) | ((kk & 4) << 1) | ((kk & 8) >> 1), col = (subt & 7) * 32 + 8 * (lane & 3);
    voff0 = (unsigned)(key * LD + 4096 + h * 256 + col) * 2u; }
  const char* kvb = (const char*)qkvb;
  const long tstep = 64L * LD * 2;
#define DMA_K1(g_, b, i_) __builtin_amdgcn_global_load_lds((const unsigned*)((g_) + (((i_) & 1) * 32 * LD * 2 + ((i_) >> 1) * 256) + koff0), (__attribute__((address_space(3))) unsigned*)(ldsb + (b) * STAGE + (wid + 8 * (i_)) * 1024), 16, 0, 0)
#define DMA_V1(g_, b, i_) __builtin_amdgcn_global_load_lds((const unsigned*)((g_) + ((i_) * 16 * LD * 2) + voff0), (__attribute__((address_space(3))) unsigned*)(ldsb + (b) * STAGE + V_OFF + (wid + 8 * (i_)) * 1024), 16, 0, 0)
  const int NT = seq / 64;
  const float cL = __int_as_float(__builtin_amdgcn_readfirstlane(__float_as_int(tab[0]))), cR = __int_as_float(__builtin_amdgcn_readfirstlane(__float_as_int(tab[256])));
  ldsc_t kp[4];
#pragma unroll
  for (int d = 0; d < 4; ++d) kp[d] = (ldsc_t)ldsb + (mapw * 16384 + r32 * 256 + ((d * 32 + hi * 16) ^ ((r32 & 15) << 4)));
  const int kd = (r32 & 8) ? -128 : 128;
  const ldsc_t vp = (ldsc_t)ldsb + (V_OFF + v_rd_base(lane));
  { _Pragma("unroll") for (int i = 0; i < 4; ++i) { DMA_K1(kvb, 0, i); DMA_V1(kvb, 0, i); } }
  asm volatile("s_waitcnt vmcnt(0)" : "+v"(qr[0]), "+v"(qr[1]), "+v"(qr[2]), "+v"(qr[3]), "+v"(qr[4]), "+v"(qr[5]), "+v"(qr[6]), "+v"(qr[7]) :: "memory");
  for (int j = 0; j < NT; ++j) {
    const int bo = (j & 1) * STAGE; const int bn = (j + 1) & 1; const bool more = j + 1 < NT;
    const char* gn = kvb + (long)(j + 1) * tstep;
    asm volatile("s_waitcnt vmcnt(0)" ::: "memory");
    asm volatile("" ::: "memory"); __builtin_amdgcn_s_barrier(); asm volatile("" ::: "memory");
    {
      f32x16 p0, p1; bf16x8 pa0, pa1;
      qk_sub(p0, kp[0] + bo, kp[1] + bo, kp[2] + bo, kp[3] + bo, kd, qr, [&](int i) { if (more) DMA_K1(gn, bn, i); });
      qk_sub(p1, kp[0] + bo + 8192, kp[1] + bo + 8192, kp[2] + bo + 8192, kp[3] + bo + 8192, kd, qr, [](int) {});
      { VG g0 = vload<0, 0>(vp + bo), g1 = vload<1, 0>(vp + bo);
        softmax_sub(p0, m_reg, l_reg, pa0, pa1, o, al_l, r32, hi, 64 * j - q0w, tab, cL, cR);
        pv_run<0>(o, vp + bo, g0, g1, pa0, pa1, [&](int i) { if (more && i < 4) DMA_V1(gn, bn, i); }); }
      { VG g0 = vload<0, 1>(vp + bo), g1 = vload<1, 1>(vp + bo);
        softmax_sub(p1, m_reg, l_reg, pa0, pa1, o, al_l, r32, hi, 64 * j + 32 - q0w, tab, cL, cR);
        pv_run<1>(o, vp + bo, g0, g1, pa0, pa1, [](int) {}); }
    }
  }
  if (hi == 0) li_l[r32] = l_reg; asm volatile("s_waitcnt lgkmcnt(0)" ::: "memory");
  float rli[16];
#pragma unroll
  for (int r = 0; r < 16; ++r) rli[r] = __builtin_amdgcn_rcpf(li_l[crow(r, hi)]);
  typedef __attribute__((address_space(3))) float* ldsf_t;
  const ldsf_t df = (ldsf_t)ldsb + (rg * 32 + 4 * hi) * 256;
  asm volatile("s_waitcnt lgkmcnt(0)" ::: "memory"); __builtin_amdgcn_s_barrier(); asm volatile("" ::: "memory");
  if (mapw) {
#pragma unroll
    for (int r = 0; r < 16; ++r)
#pragma unroll
      for (int d = 0; d < 8; ++d) df[((r & 3) + 8 * (r >> 2)) * 256 + ((d * 32 + r32) ^ ((d >> 1) << 2) ^ ((r & 3) << 4))] = -lam * o[d][r] * rli[r];
  }
  asm volatile("s_waitcnt lgkmcnt(0)" ::: "memory"); __builtin_amdgcn_s_barrier(); asm volatile("" ::: "memory");
  if (!mapw) {
#pragma unroll
    for (int r = 0; r < 16; ++r)
#pragma unroll
      for (int d = 0; d < 8; ++d) { const ldsf_t p_ = df + (((r & 3) + 8 * (r >> 2)) * 256 + ((d * 32 + r32) ^ ((d >> 1) << 2) ^ ((r & 3) << 4))); *p_ = *p_ + o[d][r] * rli[r]; }
  }
#undef DMA_K1
#undef DMA_V1
}
#undef SBAR
}

constexpr int NWAVES = 8;
constexpr int DM = 2048, TOK = 65536, TC = 16384, NCHUNK = 4, DEPTH = 2;
constexpr int INW = 11264, QKVW = 6144, GATEW = 4096, DFF = 5632, NIN = 10240;
constexpr float LN_EPS = 1e-5f;
constexpr float ALPHA = 1.4142135623730951f;

constexpr size_t MiB = 1u << 20;
constexpr size_t WS_CTL = 0, CTL_ZERO_BYTES = 32768;
constexpr size_t WS_DFT1 = 1 * MiB;
constexpr size_t WS_M2P = 2 * MiB;
constexpr size_t WS_M2S = 4 * MiB;
constexpr size_t WS_W = 12 * MiB;
constexpr size_t W_IN = 0, W_F = 40 * MiB, W_A = 48 * MiB, W_F2 = 56 * MiB, W_O = 60 * MiB, W_GU = 68 * MiB, W_D = 112 * MiB, W_LAYER = 134 * MiB;
constexpr size_t WS_XB = WS_W + 2 * W_LAYER;
constexpr size_t WS_QKV = WS_XB + 64 * MiB;
constexpr size_t WS_GATE = WS_QKV + 192 * MiB;
constexpr size_t WS_Z = WS_GATE + 128 * MiB;
constexpr size_t WS_G2 = WS_Z + 64 * MiB;
constexpr size_t WS_O = WS_G2 + 64 * MiB;
constexpr size_t WS_MUST = WS_O + 64 * MiB;
constexpr size_t WS_RB = WS_MUST + 1 * MiB;
constexpr size_t WS_C1P = WS_RB + 64 * MiB;
constexpr size_t WS_C2P = WS_C1P + 3 * MiB;
constexpr size_t WS_C12 = WS_C2P + 3 * MiB;
constexpr size_t WS_STATP = WS_C12 + 1 * MiB;
constexpr size_t WS_END = WS_STATP + 1 * MiB;
constexpr int CW_BAR = 4096;

constexpr int RING_OFF = 0, RING_BYTES = 131072;
constexpr int LDSCTL_OFF = RING_BYTES, MISC_OFF = LDSCTL_OFF + 320;
constexpr int WSC_OFF = RING_BYTES + 512;
constexpr int TAB_OFF = WSC_OFF + 2048;
constexpr int LRED_OFF = TAB_OFF + 8320;
constexpr int LDS_BYTES = 151552;

#define GAS __attribute__((address_space(1)))
#define LAS __attribute__((address_space(3)))
typedef unsigned short bf16;
typedef unsigned v4u __attribute__((ext_vector_type(4)));
typedef unsigned v2u __attribute__((ext_vector_type(2)));
typedef float f32x4 __attribute__((ext_vector_type(4)));
typedef GAS unsigned gu32;
#define RLX_AGENT __ATOMIC_RELAXED, __HIP_MEMORY_SCOPE_AGENT
#define LDS_WAIT() asm volatile("s_waitcnt lgkmcnt(0)" ::: "memory")
#define VM_WAIT() asm volatile("s_waitcnt vmcnt(0)" ::: "memory")
__device__ __forceinline__ unsigned f2bf(float f) { unsigned u = __builtin_bit_cast(unsigned, f); return (u + 0x7fffu + ((u >> 16) & 1u)) >> 16; }
__device__ __forceinline__ unsigned pk2(float lo, float hi) { return f2bf(lo) | (f2bf(hi) << 16); }

#define XB_TMO      128
#define XB_XCNT(j)  (256  + 64 * (j))
#define XB_XSUB(j)  (1280 + 64 * (j))
#define XB_XGEN(j)  (2304 + 64 * (j))
#define XB_TOP      3328
#define XB_TOPGEN   3392
#define XCD_BAR_WORDS 3456
#define XB_SPIN_CAP (1u << 21)

__device__ __forceinline__ unsigned xb_ld(unsigned* p)              { return __hip_atomic_load(p, __ATOMIC_RELAXED, __HIP_MEMORY_SCOPE_AGENT); }
__device__ __forceinline__ unsigned xb_add(unsigned* p, unsigned v) { return __hip_atomic_fetch_add(p, v, __ATOMIC_RELAXED, __HIP_MEMORY_SCOPE_AGENT); }
__device__ __forceinline__ unsigned xb_xcc_id() { return (unsigned)__builtin_amdgcn_s_getreg((3 << 11) | 20) & 0xFu; }
#define XB_SPIN(cond, bar) do { unsigned _sp = 0; while (cond) { __builtin_amdgcn_s_sleep(1); \
    if ((++_sp & 255u) == 0u) { if (xb_ld(&(bar)[XB_TMO])) break; if (_sp > XB_SPIN_CAP) { atomicAdd(&(bar)[XB_TMO], 1u); break; } } } } while (0)

struct XcdBarrier {
    unsigned* bar; unsigned x;
    volatile LAS unsigned* st;
};
__device__ __forceinline__ XcdBarrier xcd_barrier_post(unsigned* bar, volatile LAS unsigned* st) {
    XcdBarrier b; b.bar = bar; b.x = xb_xcc_id(); b.st = st;
    if (threadIdx.x == 0) (void)xb_add(&bar[XB_XCNT(b.x)], 1u);
    return b;
}
__device__ __forceinline__ void xcd_barrier_complete(unsigned* bar, unsigned x, unsigned& nloc, unsigned& nx) {
    const unsigned G = gridDim.x * gridDim.y * gridDim.z;
    unsigned sum, cnt, mine, sp = 0u;
    for (;;) {
        sum = 0u; cnt = 0u; mine = 0u;
#pragma unroll
        for (unsigned j = 0; j < 16; ++j) { const unsigned c = xb_ld(&bar[XB_XCNT(j)]); sum += c; cnt += (c > 0u) ? 1u : 0u; mine = (j == x) ? c : mine; }
        if (sum == G) break;
        __builtin_amdgcn_s_sleep(1);
        if ((++sp & 255u) == 0u) { if (xb_ld(&bar[XB_TMO])) break; if (sp > XB_SPIN_CAP) { atomicAdd(&bar[XB_TMO], 1u); break; } }
    }
    nloc = mine > 0u ? mine : 1u; nx = cnt > 0u ? cnt : 1u;
}
__device__ __forceinline__ void xcd_barrier(const XcdBarrier& b) {
    asm volatile("s_waitcnt vmcnt(0)" ::: "memory");
    __syncthreads();
    unsigned t0_ = threadIdx.x; asm volatile("" : "+v"(t0_));
    if (t0_ == 0) {
        unsigned* bar = b.bar;
        __builtin_amdgcn_s_waitcnt(0);
        unsigned nloc = b.st[0], nx = b.st[1];
        if (nloc == 0u) { xcd_barrier_complete(bar, b.x, nloc, nx); b.st[0] = nloc; b.st[1] = nx; }
        const unsigned old = xb_add(&bar[XB_XSUB(b.x)], 1u);
        const unsigned gen = old / nloc;
        if (old + 1u == (gen + 1u) * nloc) {
            __builtin_amdgcn_fence(__ATOMIC_RELEASE, "agent");
            asm volatile("s_waitcnt vmcnt(0)" ::: "memory");
            const unsigned og = xb_add(&bar[XB_TOP], 1u);
            const unsigned tg = og / nx;
            if (og + 1u == (tg + 1u) * nx) xb_add(&bar[XB_TOPGEN], 1u);
            else XB_SPIN(xb_ld(&bar[XB_TOPGEN]) == tg, bar);
            __builtin_amdgcn_fence(__ATOMIC_ACQUIRE, "agent");
            xb_add(&bar[XB_XGEN(b.x)], 1u);
            asm volatile("s_waitcnt vmcnt(0)" ::: "memory");
        } else {
            XB_SPIN(xb_ld(&bar[XB_XGEN(b.x)]) == gen, bar);
            __builtin_amdgcn_fence(__ATOMIC_ACQUIRE, "agent");
            asm volatile("s_waitcnt vmcnt(0)" ::: "memory");
        }
    }
    __syncthreads();
}

struct Frame {
    LAS unsigned char* lds;
    int tid, lane, wave;
    int vcu, G;
};
__device__ __forceinline__ float wave_sum(float v, int lane) {
#pragma unroll
    for (int o = 1; o < 64; o <<= 1) v += __uint_as_float((unsigned)__builtin_amdgcn_ds_bpermute((lane ^ o) << 2, (int)__float_as_uint(v)));
    return v;
}
#define PHASE_TID() do { int t_ = threadIdx.x; asm volatile("" : "+v"(t_)); F.tid = t_; F.lane = t_ & 63; F.wave = __builtin_amdgcn_readfirstlane(t_ >> 6); asm volatile("" : "+s"(F.vcu), "+s"(F.G)); } while (0)
__device__ __forceinline__ void p0_transpose_item(const float* W, size_t ldsrc, int srccol0, int k0, bf16* WT, size_t Kd, int dstrow0, LAS float* scr, int lane) {
#pragma unroll 8
    for (int i = 0; i < 32; ++i) { const int kk = 2 * i + (lane >> 5); scr[kk * 33 + (lane & 31)] = W[(size_t)(k0 + kk) * ldsrc + srccol0 + (lane & 31)]; }
    LDS_WAIT(); asm volatile("" ::: "memory");
    const int c = lane & 7;
#pragma unroll
    for (int j = 0; j < 4; ++j) { const int n = (lane >> 3) + 8 * j; const LAS float* s = scr + (8 * c) * 33 + n;
        v4u o; o.x = pk2(s[0 * 33], s[1 * 33]); o.y = pk2(s[2 * 33], s[3 * 33]); o.z = pk2(s[4 * 33], s[5 * 33]); o.w = pk2(s[6 * 33], s[7 * 33]);
        *(GAS v4u*)(WT + (size_t)(dstrow0 + n) * Kd + k0 + 8 * c) = o; }
    LDS_WAIT(); asm volatile("" ::: "memory");
}
__device__ __forceinline__ void p0_transpose_item_g(const float* W, size_t ldsrc, int srccol0, int k0, bf16* WT, size_t Kd, int dstrow0, LAS float* scr, int lane, const float* gam, const float* bet, float* c1p, float* c2p) {
    float s1 = 0.f, s2 = 0.f;
#pragma unroll 8
    for (int i = 0; i < 32; ++i) { const int kk = 2 * i + (lane >> 5); const float w = W[(size_t)(k0 + kk) * ldsrc + srccol0 + (lane & 31)];
        const float wr = __uint_as_float(f2bf(w * gam[k0 + kk]) << 16); scr[kk * 33 + (lane & 31)] = wr; s1 += wr; s2 += bet[k0 + kk] * w; }
    s1 += __uint_as_float((unsigned)__builtin_amdgcn_ds_bpermute((lane ^ 32) << 2, (int)__float_as_uint(s1)));
    s2 += __uint_as_float((unsigned)__builtin_amdgcn_ds_bpermute((lane ^ 32) << 2, (int)__float_as_uint(s2)));
    if (lane < 32) { c1p[dstrow0 + lane] = s1; c2p[dstrow0 + lane] = s2; }
    LDS_WAIT(); asm volatile("" ::: "memory");
    const int c = lane & 7;
#pragma unroll
    for (int j = 0; j < 4; ++j) { const int n = (lane >> 3) + 8 * j; const LAS float* s = scr + (8 * c) * 33 + n;
        v4u o; o.x = pk2(s[0 * 33], s[1 * 33]); o.y = pk2(s[2 * 33], s[3 * 33]); o.z = pk2(s[4 * 33], s[5 * 33]); o.w = pk2(s[6 * 33], s[7 * 33]);
        *(GAS v4u*)(WT + (size_t)(dstrow0 + n) * Kd + k0 + 8 * c) = o; }
    LDS_WAIT(); asm volatile("" ::: "memory");
}
__device__ __forceinline__ void ln_rows(const Frame& F, const float* src, float* dstf, bf16* dstb, float* must, const float* gam, const float* bet, int nrows, bool poison) {
    const int gw = F.vcu * NWAVES + F.wave, NGW = F.G * NWAVES;
    f32x4 vn[8];
    if (gw < nrows) { const GAS f32x4* xr = (const GAS f32x4*)(src + (size_t)gw * DM) + F.lane;
#pragma unroll
        for (int j = 0; j < 8; ++j) vn[j] = xr[64 * j]; }
    for (int m = gw; m < nrows; m += NGW) {
        f32x4 v[8]; float s = 0.f;
#pragma unroll
        for (int j = 0; j < 8; ++j) { v[j] = vn[j]; s += (v[j].x + v[j].y) + (v[j].z + v[j].w); }
        if (m + NGW < nrows) { const GAS f32x4* xr = (const GAS f32x4*)(src + (size_t)(m + NGW) * DM) + F.lane;
#pragma unroll
            for (int j = 0; j < 8; ++j) vn[j] = xr[64 * j]; }
        const float mean = wave_sum(s, F.lane) * (1.f / DM); float s2 = 0.f;
#pragma unroll
        for (int j = 0; j < 8; ++j) { v[j] = v[j] - mean; s2 += (v[j].x * v[j].x + v[j].y * v[j].y) + (v[j].z * v[j].z + v[j].w * v[j].w); }
        const float rstd = 1.f / sqrtf(wave_sum(s2, F.lane) * (1.f / DM) + LN_EPS);
        if (must && F.lane == 0) { float2 o2; o2.x = mean; o2.y = rstd; *(float2*)(must + (size_t)m * 2) = o2; }
        GAS f32x4* of = (GAS f32x4*)(dstf + (size_t)m * DM) + F.lane;
#pragma unroll
        for (int j = 0; j < 8; ++j) { const f32x4 g = ((const GAS f32x4*)gam)[64 * j + F.lane], b = ((const GAS f32x4*)bet)[64 * j + F.lane];
            f32x4 o = v[j] * rstd * g + b;
            if (poison) { const float q = __builtin_nanf(""); o = (f32x4){q, q, q, q}; }
            if (dstf) of[64 * j] = o;
            if (dstb) { v2u w; w.x = pk2(o.x, o.y); w.y = pk2(o.z, o.w); ((GAS v2u*)(dstb + (size_t)m * DM))[64 * j + F.lane] = w; } }
    }
}
__device__ __forceinline__ void ln_rows_b(const Frame& F, const bf16* src, float* dstf, bf16* dstb, float* must, const float* gam, const float* bet, int nrows, bool poison) {
    const int gw = F.vcu * NWAVES + F.wave, NGW = F.G * NWAVES;
    v4u wn[4];
    if (gw < nrows) { const GAS v4u* xr = (const GAS v4u*)(src + (size_t)gw * DM) + F.lane;
#pragma unroll
        for (int j = 0; j < 4; ++j) wn[j] = xr[64 * j]; }
    for (int m = gw; m < nrows; m += NGW) {
        v4u wc[4];
#pragma unroll
        for (int j = 0; j < 4; ++j) wc[j] = wn[j];
        if (m + NGW < nrows) { const GAS v4u* xr = (const GAS v4u*)(src + (size_t)(m + NGW) * DM) + F.lane;
#pragma unroll
            for (int j = 0; j < 4; ++j) wn[j] = xr[64 * j]; }
        float v[4][8]; float s = 0.f;
#pragma unroll
        for (int j = 0; j < 4; ++j) { const v4u w = wc[j];
            v[j][0] = __uint_as_float(w.x << 16); v[j][1] = __uint_as_float(w.x & 0xffff0000u); v[j][2] = __uint_as_float(w.y << 16); v[j][3] = __uint_as_float(w.y & 0xffff0000u);
            v[j][4] = __uint_as_float(w.z << 16); v[j][5] = __uint_as_float(w.z & 0xffff0000u); v[j][6] = __uint_as_float(w.w << 16); v[j][7] = __uint_as_float(w.w & 0xffff0000u);
#pragma unroll
            for (int e = 0; e < 8; ++e) s += v[j][e]; }
        const float mean = wave_sum(s, F.lane) * (1.f / DM); float s2 = 0.f;
#pragma unroll
        for (int j = 0; j < 4; ++j)
#pragma unroll
            for (int e = 0; e < 8; ++e) { v[j][e] -= mean; s2 += v[j][e] * v[j][e]; }
        const float rstd = 1.f / sqrtf(wave_sum(s2, F.lane) * (1.f / DM) + LN_EPS);
        if (must && F.lane == 0) { float2 o2; o2.x = mean; o2.y = rstd; *(float2*)(must + (size_t)m * 2) = o2; }
#pragma unroll
        for (int j = 0; j < 4; ++j) { const int c0 = (64 * j + F.lane) * 8;
            const f32x4 g0 = *(const GAS f32x4*)(gam + c0), g1 = *(const GAS f32x4*)(gam + c0 + 4), b0 = *(const GAS f32x4*)(bet + c0), b1 = *(const GAS f32x4*)(bet + c0 + 4);
            f32x4 o0 = (f32x4){v[j][0], v[j][1], v[j][2], v[j][3]} * rstd * g0 + b0, o1 = (f32x4){v[j][4], v[j][5], v[j][6], v[j][7]} * rstd * g1 + b1;
            if (poison) { const float q = __builtin_nanf(""); o0 = (f32x4){q, q, q, q}; o1 = o0; }
            if (dstf) { *(GAS f32x4*)(dstf + (size_t)m * DM + c0) = o0; *(GAS f32x4*)(dstf + (size_t)m * DM + c0 + 4) = o1; }
            if (dstb) { v4u w; w.x = pk2(o0.x, o0.y); w.y = pk2(o0.z, o0.w); w.z = pk2(o1.x, o1.y); w.w = pk2(o1.z, o1.w); *(GAS v4u*)(dstb + (size_t)m * DM + c0) = w; } }
    }
}
__device__ __forceinline__ int rel_bucket(int rel) {
    const int ret = rel > 0 ? 16 : 0; const int n = rel < 0 ? -rel : rel; int v;
    if (n < 8) v = n; else { const int large = 8 + ((31 - __clz(n * n)) - 6); v = large < 15 ? large : 15; }
    return ret + v;
}

struct Args { const float* in[18]; float* out; unsigned char* ws; int ph_lo, ph_hi; unsigned char* wsp[17]; unsigned char* pad_; };
typedef const void* __attribute__((address_space(4))) const kslot_t;
__device__ __forceinline__ const void* karg(int i) { asm volatile("" : "+s"(i)); return ((kslot_t*)__builtin_amdgcn_kernarg_segment_ptr())[i]; }
#define KIN(i) ((const float*)karg(i))
#define KOUT ((float*)karg(18))
#define KWS ((unsigned char*)karg(19))
constexpr int PH_PER_IT = 10, N_IT = NCHUNK * DEPTH, PH_TOTAL = 1 + N_IT * PH_PER_IT + 1;

__global__ void __launch_bounds__(NWAVES * 64, 2) fwd_kernel(Args args) {
    extern __shared__ __attribute__((aligned(16))) unsigned char lds[];
    Frame F;
    F.lds = (LAS unsigned char*)lds;
    volatile LAS unsigned* MISC = (volatile LAS unsigned*)(F.lds + MISC_OFF);
    F.tid = threadIdx.x; F.lane = F.tid & 63; F.wave = __builtin_amdgcn_readfirstlane(F.tid >> 6);
    F.G = gridDim.x; { const int bx = blockIdx.x; F.vcu = (F.G % 8 == 0) ? (bx % 8) * (F.G / 8) + bx / 8 : bx; }
    gu32* ctl = (gu32*)(args.ws + WS_CTL);
    for (int u = F.tid; u < (WSC_OFF - LDSCTL_OFF) / 4; u += NWAVES * 64) ((LAS unsigned*)(F.lds + LDSCTL_OFF))[u] = 0u;
    { LAS float* tabS = (LAS float*)(F.lds + TAB_OFF);
      for (int e = F.tid; e < 8 * 257; e += NWAVES * 64) { const int h = e / 257, i = e % 257; tabS[h * 260 + i] = args.in[2][rel_bucket(i - 128) * 8 + h] * 11.313708498984761f; } }
    __syncthreads();
    XcdBarrier bar; bar.bar = (unsigned*)(ctl + CW_BAR); bar.x = 0; bar.st = nullptr;
    if (!MK_PER_PHASE) bar = xcd_barrier_post((unsigned*)(ctl + CW_BAR), MISC + 8);
    const int lo = MK_PER_PHASE ? args.ph_lo : 0, hi = MK_PER_PHASE ? args.ph_hi : PH_TOTAL;
#define IN(k) (lo <= (k) && (k) < hi)
#define SEAM(k) do { if ((k) + 1 < hi) { XcdBarrier bb_ = bar; asm volatile("" : "+s"(bb_.bar), "+s"(bb_.x)); xcd_barrier(bb_); } } while (0)

#define P_XB ((bf16*)karg(21))
#define P_QKV ((bf16*)karg(22))
#define P_GATE ((bf16*)karg(23))
#define P_ZT ((bf16*)karg(24))
#define P_MERGED ((bf16*)karg(24))
#define P_G2 ((bf16*)karg(25))
#define P_OB ((bf16*)karg(26))
#define P_YB ((bf16*)karg(21))
#define P_ACT ((bf16*)karg(22))
#define P_SCR ((float*)karg(21))
#define P_DFT1 ((bf16*)karg(27))
#define P_XC (KOUT + (size_t)c * TC * DM)
#define WL(off) ((const pg8::bf16_t*)((const unsigned char*)karg(30 + l) + (unsigned)(off)))
#define P_M2(lg) ((const pg8::bf16_t*)karg((lg) == 4 ? 28 : 29))
#define P_MUST ((float*)karg(32))
#define P_RB ((bf16*)karg(33))
#define P_C1P ((float*)karg(34))
#define P_C2P ((float*)karg(35))
#define P_C12 ((float*)karg(36))
#define P_STATP ((float*)karg(37))
    if (IN(0)) {
        PHASE_TID();
        const int gw = F.vcu * NWAVES + F.wave, NGW = F.G * NWAVES;
        {
            LAS float* scr = (LAS float*)(F.lds + RING_OFF + F.wave * 16384);
            constexpr int I_IN = 32 * 320, I_A = 32 * 64, I_F2 = 16 * 64, I_O = 32 * 64, I_GU = 32 * 352, I_D = 88 * 64;
            constexpr int I_LAYER = I_IN + I_A + I_F2 + I_O + I_GU + I_D;
            for (int it = gw; it < DEPTH * I_LAYER; it += NGW) {
                const int l = it / I_LAYER; int r = it % I_LAYER;
                unsigned char* wl = (unsigned char*)karg(30 + l);
                if (r < I_IN) { const int kb = r / 320, nb = r % 320, n0 = nb * 32; const int sc = n0 < QKVW ? n0 : n0 + 1024;
                    p0_transpose_item(KIN(5) + (size_t)l * DM * INW, INW, sc, kb * 64, (bf16*)(wl + W_IN), DM, n0, scr, F.lane); continue; } r -= I_IN;
                if (r < I_A) { const int kb = r / 64, nb = r % 64; p0_transpose_item(KIN(9) + (size_t)l * DM * DM, DM, nb * 32, kb * 64, (bf16*)(wl + W_A), DM, nb * 32, scr, F.lane); continue; } r -= I_A;
                if (r < I_F2) { const int kb = r / 64, nb = r % 64; p0_transpose_item(KIN(10) + (size_t)l * 1024 * DM, DM, nb * 32, kb * 64, (bf16*)(wl + W_F2), 1024, nb * 32, scr, F.lane); continue; } r -= I_F2;
                if (r < I_O) { const int kb = r / 64, nb = r % 64; p0_transpose_item(KIN(11) + (size_t)l * DM * DM, DM, nb * 32, kb * 64, (bf16*)(wl + W_O), DM, nb * 32, scr, F.lane); continue; } r -= I_O;
                if (r < I_GU) { const int kb = r / 352, nb = r % 352, n0 = nb * 32, t = n0 >> 8, j = n0 & 255; const int sc = j < 128 ? 128 * t + j : DFF + 128 * t + (j - 128);
                    p0_transpose_item_g(KIN(14) + (size_t)l * DM * INW, INW, sc, kb * 64, (bf16*)(wl + W_GU), DM, n0, scr, F.lane, KIN(12) + (size_t)l * DM, KIN(13) + (size_t)l * DM,
                                        P_C1P + ((size_t)l * 32 + kb) * INW, P_C2P + ((size_t)l * 32 + kb) * INW); continue; } r -= I_GU;
                { const int kb = r / 64, nb = r % 64; p0_transpose_item(KIN(15) + (size_t)l * DFF * DM, DM, nb * 32, kb * 64, (bf16*)(wl + W_D), DFF, nb * 32, scr, F.lane); }
            }
        }
        __syncthreads();
        {
            const int part = F.wave >> 2, cb = F.wave & 3, r32 = F.lane & 31, hi = F.lane >> 5;
            LAS float* ctab = (LAS float*)(F.lds + RING_OFF); LAS float* stab = ctab + 128;
            if (F.tid < 128) { float sv, cv; sincospif((float)F.tid * (1.0f / 64.0f), &sv, &cv); ctab[F.tid] = cv * 0.08838834764831845f; stab[F.tid] = -sv * 0.08838834764831845f; }
            __syncthreads();
            const LAS float* tb = part ? stab : ctab;
            att3::bf16x8 th[8], tl[8];
#pragma unroll
            for (int s = 0; s < 8; ++s) { att3::u32x4 wh_, wl_;
#pragma unroll
                for (int e2 = 0; e2 < 4; ++e2) { unsigned hh[2], ll[2];
#pragma unroll
                    for (int q = 0; q < 2; ++q) { const int c = 16 * s + 8 * hi + 2 * e2 + q; const float t = tb[(c * (cb * 32 + r32)) & 127]; hh[q] = f2bf(t); ll[q] = f2bf(t - __uint_as_float(hh[q] << 16)); }
                    wh_[e2] = hh[0] | (hh[1] << 16); wl_[e2] = ll[0] | (ll[1] << 16); }
                th[s] = __builtin_bit_cast(att3::bf16x8, wh_); tl[s] = __builtin_bit_cast(att3::bf16x8, wl_); asm volatile("" : "+v"(th[s]), "+v"(tl[s])); }
            for (int item = F.vcu; item < DEPTH * 8 * 32; item += F.G) {
                const int l = item >> 8, g = (item >> 5) & 7, kb = item & 31, k0 = kb * 64;
                const float* src = KIN(5) + (size_t)l * DM * INW + (size_t)(k0 + r32) * INW + QKVW + g * 128 + 8 * hi;
                bf16* dst = (bf16*)((unsigned char*)karg(30 + l) + (unsigned)W_F) + k0 + r32;
#pragma unroll
                for (int nt = 0; nt < 2; ++nt) {
                    att3::f32x16 acc = {};
#pragma unroll
                    for (int sh = 0; sh < 2; ++sh) {
                        f32x4 w0[4], w1[4];
#pragma unroll
                        for (int s = 0; s < 4; ++s) { const GAS f32x4* p = (const GAS f32x4*)(src + (size_t)nt * 32 * INW + 16 * (sh * 4 + s)); w0[s] = p[0]; w1[s] = p[1]; }
                        __builtin_amdgcn_sched_barrier(0);
#pragma unroll
                        for (int s = 0; s < 4; ++s) { att3::u32x4 wh_, wl_;
#pragma unroll
                            for (int e2 = 0; e2 < 4; ++e2) { const float wa = e2 < 2 ? w0[s][2 * e2] : w1[s][2 * e2 - 4], wb = e2 < 2 ? w0[s][2 * e2 + 1] : w1[s][2 * e2 - 3];
                                const unsigned ha = f2bf(wa), hb = f2bf(wb); wh_[e2] = ha | (hb << 16); wl_[e2] = pk2(wa - __uint_as_float(ha << 16), wb - __uint_as_float(hb << 16)); }
                            const att3::bf16x8 wh = __builtin_bit_cast(att3::bf16x8, wh_), wl = __builtin_bit_cast(att3::bf16x8, wl_);
                            acc = __builtin_amdgcn_mfma_f32_32x32x16_bf16(th[sh * 4 + s], wh, acc, 0, 0, 0);
                            acc = __builtin_amdgcn_mfma_f32_32x32x16_bf16(th[sh * 4 + s], wl, acc, 0, 0, 0);
                            acc = __builtin_amdgcn_mfma_f32_32x32x16_bf16(tl[sh * 4 + s], wh, acc, 0, 0, 0); __builtin_amdgcn_sched_barrier(0); }
                    }
#pragma unroll
                    for (int r = 0; r < 16; ++r) { const int cp = cb * 32 + 4 * hi + (r & 3) + 8 * (r >> 2);
                        const bool ok = part ? (cp >= 1 && cp <= 63) : (cp <= 64); const int row = part ? 520 + g * 63 + cp - 1 : g * 65 + cp;
                        if (ok) dst[(size_t)row * DM + nt * 32] = (bf16)f2bf(acc[r]); if ((r & 3) == 3) __builtin_amdgcn_sched_barrier(0); }
                }
            }
        }
        {
            const int gt = F.vcu * (NWAVES * 64) + F.tid, NGT = F.G * NWAVES * 64;
            for (int e8 = gt; e8 < (256 * 256 + 8 * 256 * 512 + 32 * 256 * 512) / 8; e8 += NGT) {
                float v[8]; bf16* dst;
                if (e8 < 256 * 256 / 8) {
                    const int row = e8 >> 5, c0 = (e8 & 31) * 8, pp = row >> 7, k1 = row & 127;
#pragma unroll
                    for (int i = 0; i < 8; ++i) { const int col = c0 + i, p = col >> 7, s1 = col & 127; float sv, cv; sincospif((float)((k1 * s1) & 127) * (1.0f / 64.0f), &sv, &cv);
                        v[i] = (pp == p ? cv : (pp == 0 ? sv : -sv)) * 0.08838834764831845f; }
                    dst = P_DFT1 + (size_t)e8 * 8;
                } else {
                    int q = e8 - 256 * 256 / 8; int lgN2; bf16* base;
                    if (q < 8 * 256 * 512 / 8) { lgN2 = 4; base = (bf16*)karg(28); } else { q -= 8 * 256 * 512 / 8; lgN2 = 6; base = (bf16*)karg(29); }
                    const int N2 = 1 << lgN2, S = 128 << lgN2, gk = 256 >> lgN2;
                    const int gi = q >> 14, rem = q & 16383, m = rem >> 6, kk0 = (rem & 63) * 8;
                    const int k1l = m >> lgN2, k2 = m & (N2 - 1), k = gi * gk + k1l + 128 * k2;
                    const float sc = lgN2 == 4 ? 0.25f : 0.125f;
#pragma unroll
                    for (int i = 0; i < 8; ++i) { const int kk = kk0 + i, k1lp = kk >> (lgN2 + 1), pp = (kk >> lgN2) & 1, s2 = kk & (N2 - 1);
                        float sv, cv; sincospif((float)((s2 * k) & (S - 1)) * (2.0f / (float)S), &sv, &cv);
                        v[i] = (k1lp == k1l) ? (pp ? sv : cv) * sc : 0.f; }
                    dst = base + (size_t)q * 8;
                }
                v4u o; o.x = pk2(v[0], v[1]); o.y = pk2(v[2], v[3]); o.z = pk2(v[4], v[5]); o.w = pk2(v[6], v[7]);
                *(GAS v4u*)dst = o;
            }
        }
        SEAM(0);
    }

    for (int it = 0; it < N_IT; ++it) {
        const int c = it >> 1, l = it & 1, P = 1 + it * PH_PER_IT;
        if (hi <= P || lo >= P + PH_PER_IT) continue;
        const int lgN2 = c < 2 ? 4 : 6, S = 128 << lgN2, Bc = TC / S;

        if (IN(P + 0)) {
            PHASE_TID();
            if (it == 0) {
                const int gt = F.vcu * (NWAVES * 64) + F.tid, NGT = F.G * NWAVES * 64;
                for (int e = gt; e < 2 * 2 * INW; e += NGT) { const int ll = e / (2 * INW), which = (e / INW) & 1, n = e % INW;
                    const float* p = (which ? P_C2P : P_C1P) + (size_t)ll * 32 * INW + n; float s = 0.f;
                    for (int kb = 0; kb < 32; ++kb) s += p[(size_t)kb * INW];
                    P_C12[((size_t)ll * 2 + which) * INW + n] = s; }
            }
            if (l == 0) {
                const float* xin = c < 2 ? KIN(0) + (size_t)c * TC * DM : KIN(1) + (size_t)(c - 2) * TC * DM;
                ln_rows(F, xin, nullptr, P_XB, P_MUST, KIN(3), KIN(4), TC, false);
                if (c > 0) ln_rows_b(F, P_RB, KOUT + (size_t)(c - 1) * TC * DM, nullptr, nullptr, KIN(16) + DM, KIN(17) + DM, TC, false);

            } else {
                ln_rows_b(F, P_RB, nullptr, P_XB, P_MUST, KIN(16), KIN(17), TC, false);
            }
            SEAM(P + 0);
        }
        if (IN(P + 1)) {
            PHASE_TID();
            { pg8::ProbLin g = pg8::make_lin((const pg8::bf16_t*)P_XB, DM, WL(W_IN), DM, DM); pg8::StaticOrder So; So.init(TC, NIN, F.G, (int)blockIdx.x);
              pg8::EpiInProj E{(pg8::bf16_t*)P_QKV, (pg8::bf16_t*)P_GATE, KIN(6) + (size_t)l * GATEW};
              pg8::gemm_phase(F.lds + RING_OFF, g, So, E); }
            { pg8::ProbF0 g; g.A = (const char*)WL(W_F); g.B = (const char*)P_XB; g.lgN2 = lgN2; g.K = DM; g.rsA = DM; g.rsB = (unsigned)DM << lgN2; g.hsA = 128L * DM * 2; g.hsB = DM * 2;
              pg8::StaticOrder So; So.init(1024, TC, F.G, (int)blockIdx.x);
              pg8::EpiF0 E{(pg8::bf16_t*)P_ZT, lgN2};
              pg8::gemm_phase(F.lds + RING_OFF, g, So, E); }
            SEAM(P + 1);
        }
        if (IN(P + 2)) {
            PHASE_TID();
            float lamfull;
            { const float* lm = KIN(7) + (size_t)l * 512; const float a = lm[F.lane] * lm[128 + F.lane] + lm[64 + F.lane] * lm[192 + F.lane];
              const float b2 = lm[256 + F.lane] * lm[384 + F.lane] + lm[320 + F.lane] * lm[448 + F.lane];
              const float laminit = l == 0 ? 0.2f : 0.35550906759096926f;
              lamfull = __uint_as_float(__builtin_amdgcn_readfirstlane(__float_as_uint(__expf(wave_sum(a, F.lane)) - __expf(wave_sum(b2, F.lane)) + laminit))); }
            __syncthreads();
            const int nqb = S / 128;
            for (int ui = 0; ui < 4; ++ui) {
                const int uid = ui * F.G + F.vcu; if (uid >= Bc * 8 * nqb) break;
                const int bh = uid >> lgN2, qb = uid & (nqb - 1), b = bh >> 3, h = bh & 7;
                att3::attn_unit((const att3::bf16*)P_QKV + (size_t)b * S * QKVW, S, qb * 128, h, F.lds + RING_OFF, (float*)(lds + WSC_OFF), (const float*)(lds + TAB_OFF) + h * 260, lamfull);
                __syncthreads();
                PHASE_TID();
                {
                    const int row = F.tid >> 2, qd = F.tid & 3;
                    const LAS float* drow = (const LAS float*)(F.lds + RING_OFF) + row * 256; const int sw = (qd << 2) ^ ((row & 3) << 4);
                    f32x4 av[16]; float ssq = 0.f;
#pragma unroll
                    for (int j = 0; j < 16; ++j) { av[j] = *(const LAS f32x4*)(drow + ((qd * 64 + 4 * j) ^ sw)); ssq += (av[j].x * av[j].x + av[j].y * av[j].y) + (av[j].z * av[j].z + av[j].w * av[j].w); }
                    ssq += __uint_as_float((unsigned)__builtin_amdgcn_ds_bpermute((F.lane ^ 1) << 2, (int)__float_as_uint(ssq)));
                    ssq += __uint_as_float((unsigned)__builtin_amdgcn_ds_bpermute((F.lane ^ 2) << 2, (int)__float_as_uint(ssq)));
                    int lq = l; asm volatile("" : "+s"(lq));
                    const float oml = lq == 0 ? 0.8f : 0.64449093240903074f;
                    const float rs = oml / sqrtf(ssq * (1.0f / 256.0f) + LN_EPS);
                    const f32x4* sg = (const f32x4*)(KIN(8) + lq * 256 + qd * 64);
                    bf16* orow = P_OB + ((size_t)b * S + qb * 128 + row) * DM + h * 256 + qd * 64;
#pragma unroll
                    for (int j = 0; j < 8; ++j) { const f32x4 a = av[2 * j], c2 = av[2 * j + 1], g0 = sg[2 * j], g1 = sg[2 * j + 1];
                        v4u w; w.x = pk2(a.x * rs * g0.x, a.y * rs * g0.y); w.y = pk2(a.z * rs * g0.z, a.w * rs * g0.w); w.z = pk2(c2.x * rs * g1.x, c2.y * rs * g1.y); w.w = pk2(c2.z * rs * g1.z, c2.w * rs * g1.w);
                        *(v4u*)(orow + 8 * j) = w; }
                }
                __syncthreads();
            }
            { pg8::ProbLin g = pg8::make_lin((const pg8::bf16_t*)P_DFT1, 256, (const pg8::bf16_t*)P_ZT, 256, 256); pg8::StaticOrder So; So.init(256, TC * 8, F.G, (int)blockIdx.x);
              pg8::EpiF1 E{(pg8::bf16_t*)P_G2, lgN2};
              pg8::gemm_phase(F.lds + RING_OFF, g, So, E); }
            SEAM(P + 2);
        }
        if (IN(P + 3)) {
            PHASE_TID();
            const pg8::bf16_t* M2 = P_M2(lgN2);
            pg8::ProbLin g = pg8::make_lin(M2, 512, (const pg8::bf16_t*)P_G2, 2 * S, 512); g.bPm = 512 * 2;
            pg8::StaticOrder So; So.init(S, Bc * 1024, F.G, (int)blockIdx.x);
            pg8::EpiF2 E{(pg8::bf16_t*)P_YB, lgN2};
            pg8::gemm_phase(F.lds + RING_OFF, g, So, E);
        }
        if (IN(P + 4)) {
            PHASE_TID();
            pg8::ProbLin g = pg8::make_lin((const pg8::bf16_t*)P_OB, DM, WL(W_A), DM, DM); pg8::StaticOrder So; So.init(TC, DM, F.G, (int)blockIdx.x);
            pg8::EpiGate<false> E{(pg8::bf16_t*)P_MERGED, (const pg8::bf16_t*)P_GATE, 0};
            pg8::gemm_phase(F.lds + RING_OFF, g, So, E);
            SEAM(P + 4);
        }
        if (IN(P + 5)) {
            PHASE_TID();
            pg8::ProbLin g = pg8::make_lin((const pg8::bf16_t*)P_YB, 1024, WL(W_F2), 1024, 1024); pg8::StaticOrder So; So.init(TC, DM, F.G, (int)blockIdx.x);
            pg8::EpiGate<true> E{(pg8::bf16_t*)P_MERGED, (const pg8::bf16_t*)P_GATE, 2048};
            pg8::gemm_phase(F.lds + RING_OFF, g, So, E);
            SEAM(P + 5);
        }
        if (IN(P + 6)) {
            PHASE_TID();
            pg8::ProbLin g = pg8::make_lin((const pg8::bf16_t*)P_MERGED, DM, WL(W_O), DM, DM); pg8::StaticOrder So; So.init(TC, DM, F.G, (int)blockIdx.x);
            if (l == 0) { const float* xin = c < 2 ? KIN(0) + (size_t)c * TC * DM : KIN(1) + (size_t)(c - 2) * TC * DM;
                pg8::EpiResB<true, true> E{xin, (pg8::bf16_t*)P_RB, ALPHA, P_MUST, KIN(3), KIN(4), P_STATP, (LAS float*)(F.lds + LRED_OFF)}; pg8::gemm_phase(F.lds + RING_OFF, g, So, E); }
            else { pg8::EpiResB<false, true> E{P_RB, (pg8::bf16_t*)P_RB, ALPHA, P_MUST, KIN(16), KIN(17), P_STATP, (LAS float*)(F.lds + LRED_OFF)}; pg8::gemm_phase(F.lds + RING_OFF, g, So, E); }
            SEAM(P + 6);
        }
        if (IN(P + 7)) {
            PHASE_TID();
        }
        if (IN(P + 8)) {
            PHASE_TID();
            pg8::ProbLin g = pg8::make_lin((const pg8::bf16_t*)P_RB, DM, WL(W_GU), DM, DM); pg8::StaticOrder So; So.init(TC, 2 * DFF, F.G, (int)blockIdx.x);
            {
                pg8::Unit uu; int lastpm = -1;
                for (int i = 0; So.next(i, uu); ++i) if (uu.pm != lastpm) { lastpm = uu.pm;
                    if (F.tid < 256) { const int row = uu.pm * 256 + F.tid; const f32x4* p = (const f32x4*)(P_STATP + (size_t)row * 16); const f32x4 a = p[0], b = p[1], c2_ = p[2], d = p[3];
                        const float S1 = ((a[0] + a[2]) + (b[0] + b[2])) + ((c2_[0] + c2_[2]) + (d[0] + d[2])), Q1 = ((a[1] + a[3]) + (b[1] + b[3])) + ((c2_[1] + c2_[3]) + (d[1] + d[3]));
                        const float mu = S1 * (1.f / DM); const float var = fmaxf(Q1 * (1.f / DM) - mu * mu, 0.f);
                        float2 o2; o2.x = mu; o2.y = 1.f / sqrtf(var + LN_EPS); *(float2*)(P_MUST + (size_t)row * 2) = o2; } }
                VM_WAIT(); __syncthreads();
            }
            pg8::EpiSwiGLU E{(pg8::bf16_t*)P_ACT, P_MUST, P_C12 + (size_t)l * 2 * INW, P_C12 + ((size_t)l * 2 + 1) * INW};
            pg8::gemm_phase(F.lds + RING_OFF, g, So, E);
            SEAM(P + 8);
        }
        if (IN(P + 9)) {
            PHASE_TID();
            pg8::ProbLin g = pg8::make_lin((const pg8::bf16_t*)P_ACT, DFF, WL(W_D), DFF, DFF); pg8::StaticOrder So; So.init(TC, DM, F.G, (int)blockIdx.x);
            pg8::EpiResB<false, false> E{P_RB, (pg8::bf16_t*)P_RB, ALPHA, P_MUST, KIN(12) + (size_t)l * DM, KIN(13) + (size_t)l * DM, nullptr, (LAS float*)(F.lds + LRED_OFF)};
            pg8::gemm_phase(F.lds + RING_OFF, g, So, E);
            SEAM(P + 9);
        }
    }
    if (IN(PH_TOTAL - 1)) {
        PHASE_TID();
        bool poison = false;
        if (!MK_PER_PHASE) poison = __hip_atomic_load((gu32*)(ctl + CW_BAR + XB_TMO), RLX_AGENT) != 0u;
        ln_rows_b(F, P_RB, KOUT + (size_t)(NCHUNK - 1) * TC * DM, nullptr, nullptr, KIN(16) + DM, KIN(17) + DM, TC, poison);
    }
#undef IN
#undef SEAM
}

extern "C" void kernel_launch(void* const* d_in, const int* in_sizes, int n_in, void* d_out, int out_size, void* d_ws, size_t ws_size, hipStream_t stream) {
    static int grid = 0;
    if (grid == 0) {
        if (n_in != 18 || in_sizes[0] != TOK / 2 * DM || out_size != TOK * DM || ws_size < WS_END) {
            fprintf(stderr, "kernel_launch: shape mismatch: n_in %d in0 %d out %d ws %zu (need %zu); nothing launched\n", n_in, n_in > 0 ? in_sizes[0] : -1, out_size, ws_size, (size_t)WS_END); grid = -1; return; }
        int dev = 0, cus = 0, per_cu = 0;
        if (hipGetDevice(&dev) != hipSuccess || hipDeviceGetAttribute(&cus, hipDeviceAttributeMultiprocessorCount, dev) != hipSuccess) { grid = -1; return; }
        if (hipFuncSetAttribute((const void*)fwd_kernel, hipFuncAttributeMaxDynamicSharedMemorySize, LDS_BYTES) != hipSuccess) { fprintf(stderr, "kernel_launch: hipFuncSetAttribute failed\n"); grid = -1; return; }
        if (hipOccupancyMaxActiveBlocksPerMultiprocessor(&per_cu, (const void*)fwd_kernel, NWAVES * 64, LDS_BYTES) != hipSuccess || per_cu < 1)
            fprintf(stderr, "kernel_launch: note: occupancy query reports %d workgroups per CU\n", per_cu);
        (void)hipGetLastError();
        grid = cus;
    }
    if (grid < 0) return;
    if (hipMemsetAsync((char*)d_ws + WS_CTL, 0, CTL_ZERO_BYTES, stream) != hipSuccess) { fprintf(stderr, "kernel_launch: memset failed\n"); return; }
    Args a{};
    for (int i = 0; i < 18; ++i) a.in[i] = (const float*)d_in[i];
    a.out = (float*)d_out; a.ws = (unsigned char*)d_ws;
    { unsigned char* w = (unsigned char*)d_ws; const size_t offs[17] = {WS_XB, WS_QKV, WS_GATE, WS_Z, WS_G2, WS_O, WS_DFT1, WS_M2P, WS_M2S, WS_W, WS_W + W_LAYER, WS_MUST, WS_RB, WS_C1P, WS_C2P, WS_C12, WS_STATP};
      for (int i = 0; i < 17; ++i) a.wsp[i] = w + offs[i]; }
#if MK_PER_PHASE
    for (int p = 0; p < PH_TOTAL; ++p) { a.ph_lo = p; a.ph_hi = p + 1; hipLaunchKernelGGL(fwd_kernel, dim3(grid), dim3(NWAVES * 64), LDS_BYTES, stream, a); }
#else
    a.ph_lo = 0; a.ph_hi = PH_TOTAL;
    hipLaunchKernelGGL(fwd_kernel, dim3(grid), dim3(NWAVES * 64), LDS_BYTES, stream, a);
#endif
    const hipError_t le = hipPeekAtLastError();
    if (le != hipSuccess) fprintf(stderr, "kernel_launch: launch failed: %s\n", hipGetErrorName(le));
}
```
